# Optimizing an MI355X kernel written in HIP

```python
import jax
import jax.numpy as jnp
from jax import lax
import numpy as np

D_MODEL = 1024
BATCH = 1
SEQ = 16384
DEPTH = 4
DEC_BATCH = 8
DEC_SEQ = 32
PAST_LEN = 4096

CHUNK = 64
EPS = 1e-6
A_HEADS = 4
A_DK = 128
A_DV = 128
A_QK = A_HEADS * A_DK
A_VW = A_HEADS * A_DV
A_QKV = 2 * A_QK + A_VW
CONV_W = 4
B_HEADS = 8
B_KV_HEADS = 2
B_GROUP = B_HEADS // B_KV_HEADS
B_HD = 64
B_QW = B_HEADS * B_HD
B_KW = B_KV_HEADS * B_HD
WINDOW = 128
WIN_CHUNKS = WINDOW // CHUNK
ROPE_DIM = B_HD // 4
ROPE_THETA = 500000.0
D_MIX = A_VW + B_QW
D_IN = A_QKV + A_VW + 2 * A_HEADS + B_QW + 2 * B_KW
D_FF = 2816

kernel_name = "hybrid_stream_gdn_swa_step"


def rmsnorm(x, w):
    xf = x.astype(jnp.float32)
    y = xf * lax.rsqrt(jnp.mean(xf * xf, axis=-1, keepdims=True) + EPS)
    return (y * w.astype(jnp.float32)).astype(x.dtype)


def swiglu(h, w_in, w_out):
    gate, up = jnp.split(h @ w_in, 2, axis=-1)
    return (jax.nn.silu(gate) * up) @ w_out


def l2norm(x):
    return x * lax.rsqrt(jnp.sum(x * x, axis=-1, keepdims=True) + EPS)


def partial_rope(x, pos):
    half = ROPE_DIM // 2
    inv = jnp.power(ROPE_THETA, -jnp.arange(0, ROPE_DIM, 2, dtype=jnp.float32) / ROPE_DIM)
    ang = pos.astype(jnp.float32)[:, None] * inv[None, :]
    cos = jnp.cos(ang)[None, :, None, :]
    sin = jnp.sin(ang)[None, :, None, :]
    xf = x.astype(jnp.float32)
    x1, x2, rest = xf[..., :half], xf[..., half:ROPE_DIM], xf[..., ROPE_DIM:]
    out = jnp.concatenate([x1 * cos - x2 * sin, x2 * cos + x1 * sin, rest], axis=-1)
    return out.astype(x.dtype)


def chunked_gated_delta(q, k, v, g, beta, s0, chunk):
    B, L, H, DK = q.shape
    DV = v.shape[-1]
    n = L // chunk

    def blk(t):
        return t.reshape(B, n, chunk, H, t.shape[-1]).transpose(1, 0, 3, 2, 4)

    def blk_s(t):
        return t.reshape(B, n, chunk, H).transpose(1, 0, 3, 2)

    qc, kc, vc = blk(q), blk(k), blk(v)
    bc = blk_s(beta)
    G = jnp.cumsum(blk_s(g), axis=-1)
    idx = jnp.arange(chunk)
    causal = idx[:, None] >= idx[None, :]
    strict = idx[:, None] > idx[None, :]
    decay = jnp.exp(jnp.where(causal, G[..., :, None] - G[..., None, :], -jnp.inf))
    kk = jnp.einsum('nbhid,nbhjd->nbhij', kc, kc)
    lmat = jnp.where(strict, kk * decay * bc[..., :, None], 0.0)
    amat = lmat + jnp.eye(chunk, dtype=lmat.dtype)
    rhs = jnp.concatenate([vc * bc[..., None], kc * (bc * jnp.exp(G))[..., None]], axis=-1)
    sol = lax.linalg.triangular_solve(amat, rhs, left_side=True, lower=True, unit_diagonal=True)
    u, w = sol[..., :DV], sol[..., DV:]
    qk = jnp.einsum('nbhid,nbhjd->nbhij', qc, kc) * decay
    q_dec = qc * jnp.exp(G)[..., None]
    k_dec = kc * jnp.exp(G[..., -1:] - G)[..., None]
    g_tot = jnp.exp(G[..., -1])

    def step(S, xs):
        u_i, w_i, q_i, k_i, qk_i, gt_i = xs
        v_new = u_i - jnp.einsum('bhck,bhkv->bhcv', w_i, S)
        o = jnp.einsum('bhck,bhkv->bhcv', q_i, S) + jnp.einsum('bhij,bhjv->bhiv', qk_i, v_new)
        S = S * gt_i[..., None, None] + jnp.einsum('bhck,bhcv->bhkv', k_i, v_new)
        return S, o

    S, o = lax.scan(step, s0, (u, w, q_dec, k_dec, qk, g_tot))
    return o.transpose(1, 0, 3, 2, 4).reshape(B, L, H, DV), S


def gated_deltanet(qkv, z, b_logit, a_logit, conv_buf, s0, conv_w, a_log, dt_bias, gnorm_w, chunk):
    B, L, _ = qkv.shape
    xp = jnp.concatenate([conv_buf.astype(qkv.dtype), qkv], axis=1)
    conv = sum(xp[:, j:j + L] * conv_w[j] for j in range(CONV_W))
    new_buf = xp[:, L:]
    act = jax.nn.silu(conv.astype(jnp.float32))
    q = l2norm(act[..., :A_QK].reshape(B, L, A_HEADS, A_DK)) * (A_DK ** -0.5)
    k = l2norm(act[..., A_QK:2 * A_QK].reshape(B, L, A_HEADS, A_DK))
    v = act[..., 2 * A_QK:].reshape(B, L, A_HEADS, A_DV)
    beta = jax.nn.sigmoid(b_logit.astype(jnp.float32))
    g = -jnp.exp(a_log.astype(jnp.float32)) * jax.nn.softplus(a_logit.astype(jnp.float32) + dt_bias.astype(jnp.float32))
    o, s_new = chunked_gated_delta(q, k, v, g, beta, s0.astype(jnp.float32), chunk)
    o = o * lax.rsqrt(jnp.mean(o * o, axis=-1, keepdims=True) + EPS) * gnorm_w.astype(jnp.float32)
    o = o * jax.nn.silu(z.astype(jnp.float32).reshape(B, L, A_HEADS, A_DV))
    return o.reshape(B, L, A_VW).astype(qkv.dtype), new_buf, s_new.astype(s0.dtype)


def sink_attention(q, k, v, valid, sinks):
    s = jnp.einsum('bnqhgd,bnkhd->bnhgqk', q, k).astype(jnp.float32) * (B_HD ** -0.5)
    if valid is not None:
        s = jnp.where(valid, s, -jnp.inf)
    sk = sinks.astype(jnp.float32).reshape(B_KV_HEADS, B_GROUP)[None, None, :, :, None, None]
    m = jnp.maximum(jnp.max(s, axis=-1, keepdims=True), sk)
    p = jnp.exp(s - m)
    denom = jnp.sum(p, axis=-1, keepdims=True) + jnp.exp(sk - m)
    return jnp.einsum('bnhgqk,bnkhd->bnqhgd', (p / denom).astype(v.dtype), v)


def swa_prompt(q, k, v, sinks):
    B, L = q.shape[:2]
    n = L // CHUNK
    pad = WIN_CHUNKS * CHUNK

    def band(t):
        tp = jnp.pad(t, ((0, 0), (pad, 0), (0, 0), (0, 0))).reshape(B, n + WIN_CHUNKS, CHUNK, B_KV_HEADS, B_HD)
        return jnp.concatenate([tp[:, j:j + n] for j in range(WIN_CHUNKS + 1)], axis=2)

    kpos = (jnp.arange(n)[:, None] - WIN_CHUNKS) * CHUNK + jnp.arange((WIN_CHUNKS + 1) * CHUNK)[None, :]
    valid = (kpos >= 0)[None, :, None, None, None, :]
    o = sink_attention(q.reshape(B, n, CHUNK, B_KV_HEADS, B_GROUP, B_HD), band(k), band(v), valid, sinks)
    return o.reshape(B, L, B_QW)


def swa_sample(q, k, v, k_cache, v_cache, sinks):
    B, L = q.shape[:2]
    k_all = jnp.concatenate([k_cache.astype(k.dtype), k], axis=1)
    v_all = jnp.concatenate([v_cache.astype(v.dtype), v], axis=1)
    o = sink_attention(q.reshape(B, 1, L, B_KV_HEADS, B_GROUP, B_HD), k_all[:, None], v_all[:, None], None, sinks)
    rows = k_cache.shape[1]
    return o.reshape(B, L, B_QW), k_all[:, -rows:], v_all[:, -rows:]


def token_mix(h, pos, chunk, conv_buf, s0, k_cache, v_cache, w_in, conv_w, a_log, dt_bias, gnorm_w, sinks, w_out):
    B, L, _ = h.shape
    proj = h @ w_in
    offs = np.cumsum([A_QKV, A_VW, A_HEADS, A_HEADS, B_QW, B_KW]).tolist()
    qkv_a, z_a, b_a, a_a, q_b, k_b, v_b = jnp.split(proj, offs, axis=-1)
    o_a, new_buf, s_new = gated_deltanet(qkv_a, z_a, b_a, a_a, conv_buf, s0, conv_w, a_log, dt_bias, gnorm_w, chunk)
    q_b = partial_rope(q_b.reshape(B, L, B_HEADS, B_HD), pos)
    k_b = partial_rope(k_b.reshape(B, L, B_KV_HEADS, B_HD), pos)
    v_b = v_b.reshape(B, L, B_KV_HEADS, B_HD)
    if k_cache is None:
        o_b = swa_prompt(q_b, k_b, v_b, sinks)
        rows = min(WINDOW, PAST_LEN)
        new_k, new_v = k_b[:, L - rows:], v_b[:, L - rows:]
    else:
        o_b, new_k, new_v = swa_sample(q_b, k_b, v_b, k_cache, v_cache, sinks)
    out = jnp.concatenate([o_a, o_b], axis=-1) @ w_out
    return out, new_buf, s_new, new_k, new_v


def trunk(x, pos, chunk, conv_bufs, s0s, k_caches, v_caches,
          norm_ff1, ff1_w_in, ff1_w_out, norm_mix, w_mix_in, conv_w, a_log, dt_bias,
          gnorm_w, sinks, w_mix_out, norm_ff2, ff2_w_in, ff2_w_out, norm_final):
    bufs, states, ks, vs = [], [], [], []
    for l in range(DEPTH):
        x = x + 0.5 * swiglu(rmsnorm(x, norm_ff1[l]), ff1_w_in[l], ff1_w_out[l])
        kc = None if k_caches is None else k_caches[l]
        vc = None if v_caches is None else v_caches[l]
        o, b, s, kn, vn = token_mix(rmsnorm(x, norm_mix[l]), pos, chunk, conv_bufs[l], s0s[l], kc, vc,
                                    w_mix_in[l], conv_w[l], a_log[l], dt_bias[l], gnorm_w[l], sinks[l], w_mix_out[l])
        x = x + o
        x = x + 0.5 * swiglu(rmsnorm(x, norm_ff2[l]), ff2_w_in[l], ff2_w_out[l])
        bufs.append(b)
        states.append(s)
        ks.append(kn)
        vs.append(vn)
    return rmsnorm(x, norm_final), jnp.stack(bufs), jnp.stack(states), jnp.stack(ks), jnp.stack(vs)


def setup_inputs(seed: int = 0) -> dict:
    key = jax.random.key(seed)
    ks = jax.random.split(key, 24)
    f32 = jnp.float32

    def nrm(k, shape, scale):
        return jax.random.normal(k, shape, f32) * scale

    rows = min(WINDOW, PAST_LEN)
    dt = jnp.exp(jax.random.uniform(ks[13], (DEPTH, A_HEADS), f32, float(np.log(1e-3)), float(np.log(1e-1))))
    return {
        "x_prompt": nrm(ks[0], (BATCH, SEQ, D_MODEL), 1.0),
        "x_sample": nrm(ks[1], (DEC_BATCH, DEC_SEQ, D_MODEL), 1.0),
        "cache_conv": nrm(ks[2], (DEPTH, DEC_BATCH, CONV_W - 1, A_QKV), 1.0),
        "state_delta": nrm(ks[3], (DEPTH, DEC_BATCH, A_HEADS, A_DK, A_DV), 0.1),
        "cache_k": nrm(ks[4], (DEPTH, DEC_BATCH, rows, B_KV_HEADS, B_HD), 1.0),
        "cache_v": nrm(ks[5], (DEPTH, DEC_BATCH, rows, B_KV_HEADS, B_HD), 1.0),
        "norm_ff1": 1.0 + nrm(ks[6], (DEPTH, D_MODEL), 0.02),
        "ff1_w_in": nrm(ks[7], (DEPTH, D_MODEL, 2 * D_FF), D_MODEL ** -0.5),
        "ff1_w_out": nrm(ks[8], (DEPTH, D_FF, D_MODEL), D_FF ** -0.5),
        "norm_mix": 1.0 + nrm(ks[9], (DEPTH, D_MODEL), 0.02),
        "w_mix_in": nrm(ks[10], (DEPTH, D_MODEL, D_IN), D_MODEL ** -0.5),
        "conv_w": nrm(ks[11], (DEPTH, CONV_W, A_QKV), 0.5),
        "a_log": jnp.log(jax.random.uniform(ks[12], (DEPTH, A_HEADS), f32, 1.0, 16.0)),
        "dt_bias": dt + jnp.log(-jnp.expm1(-dt)),
        "gnorm_w": 1.0 + nrm(ks[14], (DEPTH, A_DV), 0.02),
        "sinks": nrm(ks[15], (DEPTH, B_HEADS), 1.0),
        "w_mix_out": nrm(ks[16], (DEPTH, D_MIX, D_MODEL), D_MIX ** -0.5),
        "norm_ff2": 1.0 + nrm(ks[17], (DEPTH, D_MODEL), 0.02),
        "ff2_w_in": nrm(ks[18], (DEPTH, D_MODEL, 2 * D_FF), D_MODEL ** -0.5),
        "ff2_w_out": nrm(ks[19], (DEPTH, D_FF, D_MODEL), D_FF ** -0.5),
        "norm_final": 1.0 + nrm(ks[20], (D_MODEL,), 0.02),
    }


def reference(x_prompt, x_sample, cache_conv, state_delta, cache_k, cache_v,
              norm_ff1, ff1_w_in, ff1_w_out, norm_mix, w_mix_in, conv_w, a_log, dt_bias,
              gnorm_w, sinks, w_mix_out, norm_ff2, ff2_w_in, ff2_w_out, norm_final):
    weights = (norm_ff1, ff1_w_in, ff1_w_out, norm_mix, w_mix_in, conv_w, a_log, dt_bias,
               gnorm_w, sinks, w_mix_out, norm_ff2, ff2_w_in, ff2_w_out, norm_final)
    bp, lp = x_prompt.shape[:2]
    zero_buf = jnp.zeros((DEPTH, bp, CONV_W - 1, A_QKV), x_prompt.dtype)
    zero_state = jnp.zeros((DEPTH, bp, A_HEADS, A_DK, A_DV), state_delta.dtype)
    pos_p = jnp.arange(lp, dtype=jnp.int32)
    y_prompt, conv_p, delta_p, k_p, v_p = trunk(x_prompt, pos_p, CHUNK, zero_buf, zero_state, None, None, *weights)
    ds = x_sample.shape[1]
    pos_s = PAST_LEN + jnp.arange(ds, dtype=jnp.int32)
    y_sample, conv_s, delta_s, k_s, v_s = trunk(x_sample, pos_s, ds, cache_conv, state_delta, cache_k, cache_v, *weights)
    return (y_prompt, y_sample, conv_p, delta_p, k_p, v_p, conv_s, delta_s, k_s, v_s)
```

```cpp
#include <hip/hip_runtime.h>
#include <hip/hip_cooperative_groups.h>
#include <cstdio>
#include <type_traits>
namespace cg = cooperative_groups;

#define LAS __attribute__((address_space(3)))
#define DI __device__ __forceinline__
typedef unsigned short bf16_t;
typedef short bf16x8 __attribute__((ext_vector_type(8)));
typedef float f32x4 __attribute__((ext_vector_type(4)));
typedef unsigned u32x2 __attribute__((ext_vector_type(2)));
typedef unsigned u32x4 __attribute__((ext_vector_type(4)));

constexpr int T_ALL = 16640, T_P = 16384, N_S = 8, L_S = 32;
constexpr int DM = 1024, DFF = 2816, DIN = 2824, LDP = 3072, DEPTH = 4;
constexpr int NCH = 256;
constexpr int N_ITEM = NCH * 4 + N_S * 4;
constexpr int LDS_BYTES = 152 * 1024;
constexpr int NTHR = 512;
constexpr float EPS = 1e-6f;


constexpr size_t al256(size_t x) { return (x + 255) & ~(size_t)255; }
constexpr size_t OFF_XRES = 0;
constexpr size_t OFF_XB = OFF_XRES + al256((size_t)T_ALL * DM * 4);
constexpr size_t OFF_WFFIN1 = OFF_XB + al256((size_t)T_ALL * DM * 2);
constexpr size_t OFF_WFFOUT1 = OFF_WFFIN1 + al256((size_t)2 * DFF * DM * 2);
constexpr size_t OFF_WMIXIN = OFF_WFFOUT1 + al256((size_t)DM * DFF * 2);
constexpr size_t OFF_WMIXOUT = OFF_WMIXIN + al256((size_t)LDP * DM * 2);
constexpr size_t OFF_WFFIN2 = OFF_WMIXOUT + al256((size_t)DM * DM * 2);
constexpr size_t OFF_WFFOUT2 = OFF_WFFIN2 + al256((size_t)2 * DFF * DM * 2);
constexpr size_t OFF_BAR = OFF_WFFOUT2 + al256((size_t)DM * DFF * 2);
constexpr size_t OFF_ACTS = OFF_BAR + al256((size_t)(3456 + 64 + 4096) * 4);
constexpr size_t OFF_GTOT = OFF_ACTS + al256((size_t)256 * DFF * 2);
constexpr size_t OFF_UNION = OFF_GTOT + al256((size_t)N_ITEM * 4);
constexpr size_t OFF_ACT = OFF_UNION;
constexpr size_t OFF_PBUF = OFF_UNION;
constexpr size_t OFF_ANEG = OFF_PBUF + al256((size_t)T_ALL * LDP * 2);
constexpr size_t OFF_BT = OFF_ANEG + al256((size_t)N_ITEM * 16384 * 2);
constexpr size_t OFF_ST = OFF_BT + al256((size_t)N_ITEM * 16384 * 2);
constexpr size_t OFF_QP = OFF_ST + al256((size_t)(N_ITEM + 1) * 16384 * 2);
constexpr size_t OFF_OP = OFF_QP + al256((size_t)N_ITEM * 8192 * 2);
constexpr size_t OFF_PART = OFF_OP + al256((size_t)N_ITEM * 8192 * 2);
constexpr size_t WS_NEED = OFF_PART + al256((size_t)11 * 256 * DM * 4);
static_assert(OFF_ACT + (size_t)T_ALL * DFF * 2 <= WS_NEED, "act fits the union");

struct Params {
    const float *x_prompt, *x_sample, *cache_conv, *state_delta, *cache_k, *cache_v;
    const float *norm_ff1, *ff1_w_in, *ff1_w_out, *norm_mix, *w_mix_in, *conv_w, *a_log, *dt_bias;
    const float *gnorm_w, *sinks, *w_mix_out, *norm_ff2, *ff2_w_in, *ff2_w_out, *norm_final;
    float* out;
    char* ws;
    __host__ __device__ __forceinline__ float* part() const { return (float*)(ws + OFF_PART); }
    __host__ __device__ __forceinline__ float* xres() const { return (float*)(ws + OFF_XRES); }
    __host__ __device__ __forceinline__ bf16_t* xb() const { return (bf16_t*)(ws + OFF_XB); }
    __host__ __device__ __forceinline__ bf16_t* act() const { return (bf16_t*)(ws + OFF_ACT); }
    __host__ __device__ __forceinline__ bf16_t* pbuf() const { return (bf16_t*)(ws + OFF_PBUF); }
    __host__ __device__ __forceinline__ bf16_t* Aneg() const { return (bf16_t*)(ws + OFF_ANEG); }
    __host__ __device__ __forceinline__ bf16_t* BT() const { return (bf16_t*)(ws + OFF_BT); }
    __host__ __device__ __forceinline__ bf16_t* Qp() const { return (bf16_t*)(ws + OFF_QP); }
    __host__ __device__ __forceinline__ bf16_t* Op() const { return (bf16_t*)(ws + OFF_OP); }
    __host__ __device__ __forceinline__ bf16_t* ST() const { return (bf16_t*)(ws + OFF_ST); }
    __host__ __device__ __forceinline__ float* gtot() const { return (float*)(ws + OFF_GTOT); }
    __host__ __device__ __forceinline__ unsigned* bar() const { return (unsigned*)(ws + OFF_BAR); }
    __host__ __device__ __forceinline__ bf16_t* act_s() const { return (bf16_t*)(ws + OFF_ACTS); }
    __host__ __device__ __forceinline__ bf16_t* w_ffin1() const { return (bf16_t*)(ws + OFF_WFFIN1); }
    __host__ __device__ __forceinline__ bf16_t* w_ffout1() const { return (bf16_t*)(ws + OFF_WFFOUT1); }
    __host__ __device__ __forceinline__ bf16_t* w_mixin() const { return (bf16_t*)(ws + OFF_WMIXIN); }
    __host__ __device__ __forceinline__ bf16_t* w_mixout() const { return (bf16_t*)(ws + OFF_WMIXOUT); }
    __host__ __device__ __forceinline__ bf16_t* w_ffin2() const { return (bf16_t*)(ws + OFF_WFFIN2); }
    __host__ __device__ __forceinline__ bf16_t* w_ffout2() const { return (bf16_t*)(ws + OFF_WFFOUT2); }
    int phase_lo, phase_hi;
};

constexpr size_t O_Y = 0;
constexpr size_t O_CONVP = (size_t)T_ALL * DM;
constexpr size_t O_DELTAP = O_CONVP + 4 * 3 * 1536;
constexpr size_t O_KP = O_DELTAP + 4 * 4 * 128 * 128;
constexpr size_t O_VP = O_KP + 4 * 128 * 128;
constexpr size_t O_CONVS = O_VP + 4 * 128 * 128;
constexpr size_t O_DELTAS = O_CONVS + 4 * 8 * 3 * 1536;
constexpr size_t O_KS = O_DELTAS + (size_t)4 * 8 * 4 * 128 * 128;
constexpr size_t O_VS = O_KS + 4 * 8 * 128 * 128;

DI float bf2f(bf16_t v) { return __uint_as_float(((unsigned)v) << 16); }
typedef float f32x2v __attribute__((ext_vector_type(2)));
typedef __bf16 bf16x2v __attribute__((ext_vector_type(2)));
DI unsigned pack2(float a, float b) { const f32x2v v = {a, b}; const bf16x2v r = __builtin_convertvector(v, bf16x2v); return __builtin_bit_cast(unsigned, r); }
DI bf16_t f2bf(float f) { return (bf16_t)(pack2(f, 0.f) & 0xffffu); }
DI float lo2f(unsigned u) { return __uint_as_float(u << 16); }
DI float hi2f(unsigned u) { return __uint_as_float(u & 0xffff0000u); }
template <int CTRL> DI float dpp_mov(float v) { return __int_as_float(__builtin_amdgcn_update_dpp(0, __float_as_int(v), CTRL, 0xf, 0xf, false)); }
DI float rl(float v, int l) { return __int_as_float(__builtin_amdgcn_readlane(__float_as_int(v), l)); }
DI float wave_sum(float v) {
    v += dpp_mov<0xB1>(v); v += dpp_mov<0x4E>(v); v += dpp_mov<0x141>(v); v += dpp_mov<0x140>(v);
    return (rl(v, 0) + rl(v, 16)) + (rl(v, 32) + rl(v, 48));
}
DI float wave_max(float v) {
    v = fmaxf(v, dpp_mov<0xB1>(v)); v = fmaxf(v, dpp_mov<0x4E>(v)); v = fmaxf(v, dpp_mov<0x141>(v)); v = fmaxf(v, dpp_mov<0x140>(v));
    return fmaxf(fmaxf(rl(v, 0), rl(v, 16)), fmaxf(rl(v, 32), rl(v, 48)));
}
DI void lds_barrier() { asm volatile("s_waitcnt lgkmcnt(0)\n\ts_barrier" ::: "memory"); }
DI int tid_opaque() { int t = threadIdx.x; asm volatile("" : "+v"(t)); return t; }
DI float silu_f(float x) { return x * __builtin_amdgcn_rcpf(1.f + __expf(-x)); }
DI void load16bf(const bf16_t* s, float (&x)[16]) {
    const u32x4 a = *(const u32x4*)s, b = *(const u32x4*)(s + 8);
#pragma unroll
    for (int e = 0; e < 4; ++e) { x[2 * e] = lo2f(a[e]); x[2 * e + 1] = hi2f(a[e]); x[8 + 2 * e] = lo2f(b[e]); x[8 + 2 * e + 1] = hi2f(b[e]); }
}


#define XB_TMO      128
#define XB_XCNT(j)  (256  + 64 * (j))
#define XB_XSUB(j)  (1280 + 64 * (j))
#define XB_XGEN(j)  (2304 + 64 * (j))
#define XB_TOP      3328
#define XB_TOPGEN   3392
#define XCD_BAR_WORDS 3456
#define XB_SPIN_CAP (1u << 20)
DI unsigned xb_ld(unsigned* p)              { return __hip_atomic_load(p, __ATOMIC_RELAXED, __HIP_MEMORY_SCOPE_AGENT); }
DI unsigned xb_add(unsigned* p, unsigned v) { return __hip_atomic_fetch_add(p, v, __ATOMIC_RELAXED, __HIP_MEMORY_SCOPE_AGENT); }
DI unsigned xb_xcc_id() { return (unsigned)__builtin_amdgcn_s_getreg((3 << 11) | 20) & 0xFu; }
#define XB_SPIN(cond, bar) do { unsigned _sp = 0; while (cond) { __builtin_amdgcn_s_sleep(1); \
    if ((++_sp & 255u) == 0u) { if (xb_ld(&(bar)[XB_TMO])) break; if (_sp > XB_SPIN_CAP) { atomicAdd(&(bar)[XB_TMO], 1u); break; } } } } while (0)
struct XcdBarrier { unsigned* bar; unsigned x; volatile LAS unsigned* st; };
DI XcdBarrier xcd_barrier_post(unsigned* bar, volatile LAS unsigned* st) {
    XcdBarrier b; b.bar = bar; b.x = xb_xcc_id(); b.st = st;
    if (threadIdx.x == 0) (void)xb_add(&bar[XB_XCNT(b.x)], 1u);
    return b;
}
DI void xcd_barrier_complete(unsigned* bar, unsigned x, unsigned& nloc, unsigned& nx) {
    const unsigned G = gridDim.x * gridDim.y * gridDim.z;
    unsigned sum, cnt, mine, sp = 0u;
    for (;;) {
        sum = 0u; cnt = 0u; mine = 0u;
#pragma unroll
        for (unsigned j = 0; j < 16; ++j) { const unsigned c = xb_ld(&bar[XB_XCNT(j)]); sum += c; cnt += (c > 0u) ? 1u : 0u; mine = (j == x) ? c : mine; }
        if (sum == G) break;
        __builtin_amdgcn_s_sleep(1);
        if ((++sp & 255u) == 0u) { if (xb_ld(&bar[XB_TMO])) break; if (sp > XB_SPIN_CAP) { atomicAdd(&bar[XB_TMO], 1u); break; } }
    }
    nloc = mine > 0u ? mine : 1u; nx = cnt > 0u ? cnt : 1u;
}
DI void xcd_barrier(const XcdBarrier& b) {
    asm volatile("s_waitcnt vmcnt(0)" ::: "memory");
    __syncthreads();
    if (threadIdx.x == 0) {
        unsigned* bar = b.bar;
        __builtin_amdgcn_s_waitcnt(0);
        unsigned nloc = b.st[0], nx = b.st[1];
        if (nloc == 0u) { xcd_barrier_complete(bar, b.x, nloc, nx); b.st[0] = nloc; b.st[1] = nx; }
        const unsigned old = xb_add(&bar[XB_XSUB(b.x)], 1u);
        const unsigned gen = old / nloc;
        if (old + 1u == (gen + 1u) * nloc) {
            __builtin_amdgcn_fence(__ATOMIC_RELEASE, "agent");
            asm volatile("s_waitcnt vmcnt(0)" ::: "memory");
            const unsigned og = xb_add(&bar[XB_TOP], 1u);
            const unsigned tg = og / nx;
            if (og + 1u == (tg + 1u) * nx) xb_add(&bar[XB_TOPGEN], 1u);
            else XB_SPIN(xb_ld(&bar[XB_TOPGEN]) == tg, bar);
            __builtin_amdgcn_fence(__ATOMIC_ACQUIRE, "agent");
            xb_add(&bar[XB_XGEN(b.x)], 1u);
            asm volatile("s_waitcnt vmcnt(0)" ::: "memory");
        } else {
            XB_SPIN(xb_ld(&bar[XB_XGEN(b.x)]) == gen, bar);
            __builtin_amdgcn_fence(__ATOMIC_ACQUIRE, "agent");
            asm volatile("s_waitcnt vmcnt(0)" ::: "memory");
        }
    }
    __syncthreads();
}

constexpr int TEAM = 32;
DI void team_barrier(unsigned* cnt, unsigned& target) {
    asm volatile("s_waitcnt vmcnt(0)" ::: "memory");
    __syncthreads();
    if (threadIdx.x == 0) {
        target += TEAM;
        __builtin_amdgcn_fence(__ATOMIC_RELEASE, "agent");
        asm volatile("s_waitcnt vmcnt(0)" ::: "memory");
        xb_add(cnt, 1u);
        unsigned sp = 0;
        while (xb_ld(cnt) < target) { __builtin_amdgcn_s_sleep(1); if (++sp > (1u << 22)) break; }
        __builtin_amdgcn_fence(__ATOMIC_ACQUIRE, "agent");
        asm volatile("s_waitcnt vmcnt(0)" ::: "memory");
    }
    __syncthreads();
}

namespace pg8 {
constexpr int BM = 256, BK = 64, HALF = 128, HTB = HALF * BK * 2, STAGE_BYTES = 8 * HTB, NXCD = 8, WGM = 8;
DI int lds_byte(int r, int c) { const int st = (r >> 4) * 2 + (c >> 5), rr = r & 15, cc = c & 31, ob = rr * 64 + cc * 2; return st * 1024 + (ob ^ (((ob >> 9) & 1) << 5)); }
DI void stage_rc(int b, int& R, int& C) { const int st = b / 1024, sb = b % 1024, swz = sb ^ (((sb >> 9) & 1) << 5); R = (st >> 1) * 16 + swz / 64; C = (st & 1) * 32 + (swz % 64) / 2; }
struct Unit { int pm, pn, koff; };
struct Gemm { const bf16_t* A; const bf16_t* Bt; int M, N, K, ld; };
struct StaticOrder {
    int nM, nN, nwg, G, c;
    DI void init(int M, int N, int G_, int c_) { nM = M / BM; nN = N / BM; nwg = nM * nN; G = G_; c = c_; }
    DI bool next(int i, Unit& u) const {
        const long L = (long)i * G + c; if (L >= nwg) return false;
        int wgid = (int)L; { const int q = nwg / NXCD, r = nwg % NXCD, xcd = wgid % NXCD, off = wgid / NXCD; wgid = (xcd < r ? xcd * (q + 1) : r * (q + 1) + (xcd - r) * q) + off; }
        const int nig = WGM * nN, gid = wgid / nig, fm = gid * WGM, gsz = (nM - fm) < WGM ? (nM - fm) : WGM;
        u.pm = fm + ((wgid % nig) % gsz); u.pn = (wgid % nig) / gsz; u.koff = 0; return true;
    }
};

template <class Epi, class Sched>
DI void gemm_phase(LAS unsigned char* lds, const Gemm g, const Sched& S, const Epi& E) {
    const int tid = tid_opaque(), wid = __builtin_amdgcn_readfirstlane(tid >> 6), lane = tid & 63, wr = wid >> 2, wc = wid & 3, fr = lane & 15, fq = lane >> 4;
    const int K = g.ld, nt = g.K / BK;
    unsigned voffA[2], voffB[2];
#pragma unroll
    for (int i = 0; i < 2; ++i) { int R, C; stage_rc(tid * 16 + i * 8192, R, C); voffA[i] = (unsigned)(R * K + C) * 2u; voffB[i] = (unsigned)(R * K + C) * 2u; }
    const size_t kstep = (size_t)(BK * 2);
    const size_t hstep = (size_t)HALF * K * 2;
    const size_t tstep = 2 * hstep;
    const unsigned ldsw = (unsigned)wid * 1024u;
    const int aoff = lds_byte(wr * 64 + fr, fq * 8), boff = lds_byte(wc * 32 + fr, fq * 8);
#define PG8_SA(b, h) (((b) * 2 + (h)) * HTB)
#define PG8_SB(b, h) ((4 + (b) * 2 + (h)) * HTB)
#define PG8_STAGE(bufoff, gbase, voff) do { _Pragma("unroll") for (int _i = 0; _i < 2; ++_i) \
        __builtin_amdgcn_global_load_lds((const unsigned*)((const char*)(gbase) + (voff)[_i]), (LAS unsigned*)(lds + (bufoff) + ldsw + _i * 8192), 16, 0, 0); } while (0)
#define PG8_LDA(dst, b, h) do { _Pragma("unroll") for (int m = 0; m < 4; ++m) _Pragma("unroll") for (int k = 0; k < 2; ++k) dst[m][k] = *(const LAS bf16x8*)(lds + PG8_SA(b, h) + aoff + m * 2048 + k * 1024); } while (0)
#define PG8_LDB(dst, b, h) do { _Pragma("unroll") for (int n = 0; n < 2; ++n) _Pragma("unroll") for (int k = 0; k < 2; ++k) dst[n][k] = *(const LAS bf16x8*)(lds + PG8_SB(b, h) + boff + n * 2048 + k * 1024); } while (0)
#define PG8_MMA(ai, bj, At, Bt) do { __builtin_amdgcn_s_setprio(1); _Pragma("unroll") for (int m = 0; m < 4; ++m) _Pragma("unroll") for (int n = 0; n < 2; ++n) _Pragma("unroll") for (int k = 0; k < 2; ++k) \
        acc[ai][bj][m][n] = __builtin_amdgcn_mfma_f32_16x16x32_bf16(Bt[n][k], At[m][k], acc[ai][bj][m][n], 0, 0, 0); __builtin_amdgcn_s_setprio(0); } while (0)
#define PG8_WAIT_V(n) asm volatile("s_waitcnt vmcnt(" #n ")" ::: "memory")
#define PG8_WAIT_L(n) asm volatile("s_waitcnt lgkmcnt(" #n ")" ::: "memory")
#define PG8_BAR __builtin_amdgcn_s_barrier()
#define PG8_SCHED __builtin_amdgcn_sched_barrier(0)
    Unit cur, nxt; int ui = 0;
    if (!S.next(0, cur)) return;
    f32x4 acc[2][2][4][2];
#pragma unroll
    for (int a = 0; a < 2; ++a)
#pragma unroll
        for (int b = 0; b < 2; ++b)
#pragma unroll
            for (int m = 0; m < 4; ++m)
#pragma unroll
                for (int n = 0; n < 2; ++n) acc[a][b][m][n] = (f32x4){0.f, 0.f, 0.f, 0.f};
    bf16x8 At[4][2], B0[2][2], B1[2][2];
    const char* cA = (const char*)g.A + (size_t)cur.pm * tstep + cur.koff; const char* cB = (const char*)g.Bt + (size_t)cur.pn * tstep + cur.koff;
    PG8_STAGE(PG8_SB(0, 0), cB, voffB); PG8_STAGE(PG8_SA(0, 0), cA, voffA); PG8_STAGE(PG8_SB(0, 1), cB + hstep, voffB); PG8_STAGE(PG8_SA(0, 1), cA + hstep, voffA);
    if (wr == 1) PG8_BAR;
    PG8_WAIT_V(4); PG8_BAR;
    PG8_STAGE(PG8_SB(1, 0), cB + kstep, voffB); PG8_STAGE(PG8_SA(1, 0), cA + kstep, voffA); PG8_STAGE(PG8_SB(1, 1), cB + hstep + kstep, voffB);
    PG8_WAIT_V(6); PG8_BAR;
    for (;;) {
        const bool has_next = S.next(ui + 1, nxt);
        const char* nA = has_next ? (const char*)g.A + (size_t)nxt.pm * tstep + nxt.koff : cA; const char* nB = has_next ? (const char*)g.Bt + (size_t)nxt.pn * tstep + nxt.koff : cB;
        for (int t = 0; t < nt; t += 2) {
            const bool last = (t == nt - 2);
            const char* a1 = cA + (size_t)(t + 1) * kstep;
            const char* a2 = last ? nA : cA + (size_t)(t + 2) * kstep; const char* b2 = last ? nB : cB + (size_t)(t + 2) * kstep;
            const char* a3 = a2 + kstep; const char* b3 = b2 + kstep;
            PG8_LDB(B0, 0, 0); PG8_SCHED; PG8_LDA(At, 0, 0); PG8_STAGE(PG8_SA(1, 1), a1 + hstep, voffA);
            PG8_WAIT_L(8); PG8_BAR; PG8_WAIT_L(0); PG8_MMA(0, 0, At, B0); PG8_BAR; PG8_SCHED;
            PG8_LDB(B1, 0, 1); PG8_STAGE(PG8_SB(0, 0), b2, voffB);
            PG8_BAR; PG8_WAIT_L(0); PG8_MMA(0, 1, At, B1); PG8_BAR;
            PG8_LDA(At, 0, 1); PG8_STAGE(PG8_SA(0, 0), a2, voffA);
            PG8_BAR; PG8_WAIT_L(0); PG8_MMA(1, 0, At, B0); PG8_BAR; PG8_SCHED;
            PG8_STAGE(PG8_SB(0, 1), b2 + hstep, voffB);
            PG8_WAIT_V(6); PG8_BAR; PG8_MMA(1, 1, At, B1); PG8_BAR;
            PG8_LDB(B0, 1, 0); PG8_SCHED; PG8_LDA(At, 1, 0); PG8_STAGE(PG8_SA(0, 1), a2 + hstep, voffA);
            PG8_WAIT_L(8); PG8_BAR; PG8_WAIT_L(0); PG8_MMA(0, 0, At, B0); PG8_BAR; PG8_SCHED;
            PG8_LDB(B1, 1, 1); PG8_STAGE(PG8_SB(1, 0), b3, voffB);
            PG8_BAR; PG8_WAIT_L(0); PG8_MMA(0, 1, At, B1); PG8_BAR;
            PG8_LDA(At, 1, 1); PG8_STAGE(PG8_SA(1, 0), a3, voffA);
            PG8_BAR; PG8_WAIT_L(0); PG8_MMA(1, 0, At, B0); PG8_BAR; PG8_SCHED;
            PG8_STAGE(PG8_SB(1, 1), b3 + hstep, voffB);
            PG8_WAIT_V(6); PG8_BAR; PG8_MMA(1, 1, At, B1); PG8_BAR;
        }
        E(acc, cur, wr, wc, fr, fq);
        if (!has_next) break;
#pragma unroll
        for (int a = 0; a < 2; ++a)
#pragma unroll
            for (int b = 0; b < 2; ++b)
#pragma unroll
                for (int m = 0; m < 4; ++m)
#pragma unroll
                    for (int n = 0; n < 2; ++n) acc[a][b][m][n] = (f32x4){0.f, 0.f, 0.f, 0.f};
        cur = nxt; cA = nA; cB = nB; ++ui;
    }
    PG8_WAIT_V(0);
    if (wr == 0) PG8_BAR;
    PG8_BAR;
#undef PG8_SA
#undef PG8_SB
#undef PG8_STAGE
#undef PG8_LDA
#undef PG8_LDB
#undef PG8_MMA
#undef PG8_WAIT_V
#undef PG8_WAIT_L
#undef PG8_BAR
#undef PG8_SCHED
}
struct SplitKOrder {
    int nN, nS, ksub, G, c;
    DI bool next(int i, Unit& u) const {
        const int L = i * G + c; if (L >= nN * nS) return false;
        u.pm = 0; u.pn = L % nN; u.koff = (L / nN) * ksub * 2; return true;
    }
};
struct EpiSwiglu {
    bf16_t* O; int row0; bf16_t* O2;
    DI void operator()(const f32x4 (&acc)[2][2][4][2], const Unit& u, int wr, int wc, int fr, int fq) const {
        bf16_t* Ob = (row0 + u.pm * 256 >= T_P) ? O2 - (size_t)T_P * DFF : O;
#pragma unroll
        for (int ai = 0; ai < 2; ++ai)
#pragma unroll
            for (int m = 0; m < 4; ++m) {
                const size_t r = (size_t)row0 + u.pm * 256 + ai * 128 + wr * 64 + m * 16 + fr;
#pragma unroll
                for (int n = 0; n < 2; ++n) {
                    const f32x4 g = acc[ai][0][m][n], up = acc[ai][1][m][n];
                    u32x2 o; o[0] = pack2(silu_f(g[0]) * up[0], silu_f(g[1]) * up[1]); o[1] = pack2(silu_f(g[2]) * up[2], silu_f(g[3]) * up[3]);
                    *(u32x2*)(Ob + r * DFF + u.pn * 128 + wc * 32 + n * 16 + fq * 4) = o;
                }
            }
    }
};
struct EpiResid {
    float* X; float scale; int row0;
    DI void operator()(const f32x4 (&acc)[2][2][4][2], const Unit& u, int wr, int wc, int fr, int fq) const {
#pragma unroll
        for (int ai = 0; ai < 2; ++ai)
#pragma unroll
            for (int m = 0; m < 4; ++m) {
                const size_t r = (size_t)row0 + u.pm * 256 + ai * 128 + wr * 64 + m * 16 + fr;
#pragma unroll
                for (int bj = 0; bj < 2; ++bj)
#pragma unroll
                    for (int n = 0; n < 2; ++n) {
                        float* ptr = X + r * DM + u.pn * 256 + bj * 128 + wc * 32 + n * 16 + fq * 4;
                        f32x4 v = *(f32x4*)ptr; v += acc[ai][bj][m][n] * scale; *(f32x4*)ptr = v;
                    }
            }
    }
};
struct EpiPartial {
    float* P;
    DI void operator()(const f32x4 (&acc)[2][2][4][2], const Unit& u, int wr, int wc, int fr, int fq) const {
        const size_t ks = (size_t)(u.koff >> 9);
#pragma unroll
        for (int ai = 0; ai < 2; ++ai)
#pragma unroll
            for (int m = 0; m < 4; ++m) {
                const size_t r = ks * 256 + ai * 128 + wr * 64 + m * 16 + fr;
#pragma unroll
                for (int bj = 0; bj < 2; ++bj)
#pragma unroll
                    for (int n = 0; n < 2; ++n) *(f32x4*)(P + r * DM + u.pn * 256 + bj * 128 + wc * 32 + n * 16 + fq * 4) = acc[ai][bj][m][n];
            }
    }
};
struct EpiResidAtomic {
    float* X; float scale; int row0;
    DI void operator()(const f32x4 (&acc)[2][2][4][2], const Unit& u, int wr, int wc, int fr, int fq) const {
#pragma unroll
        for (int ai = 0; ai < 2; ++ai)
#pragma unroll
            for (int m = 0; m < 4; ++m) {
                const size_t r = (size_t)row0 + u.pm * 256 + ai * 128 + wr * 64 + m * 16 + fr;
#pragma unroll
                for (int bj = 0; bj < 2; ++bj)
#pragma unroll
                    for (int n = 0; n < 2; ++n) {
                        float* ptr = X + r * DM + u.pn * 256 + bj * 128 + wc * 32 + n * 16 + fq * 4;
#pragma unroll
                        for (int e = 0; e < 4; ++e) unsafeAtomicAdd(ptr + e, acc[ai][bj][m][n][e] * scale);
                    }
            }
    }
};
struct EpiBf16 {
    bf16_t* O; int ldc; int row0;
    DI void operator()(const f32x4 (&acc)[2][2][4][2], const Unit& u, int wr, int wc, int fr, int fq) const {
#pragma unroll
        for (int ai = 0; ai < 2; ++ai)
#pragma unroll
            for (int m = 0; m < 4; ++m) {
                const size_t r = (size_t)row0 + u.pm * 256 + ai * 128 + wr * 64 + m * 16 + fr;
#pragma unroll
                for (int bj = 0; bj < 2; ++bj)
#pragma unroll
                    for (int n = 0; n < 2; ++n) {
                        const f32x4 a = acc[ai][bj][m][n];
                        u32x2 o; o[0] = pack2(a[0], a[1]); o[1] = pack2(a[2], a[3]);
                        *(u32x2*)(O + r * ldc + u.pn * 256 + bj * 128 + wc * 32 + n * 16 + fq * 4) = o;
                    }
            }
    }
};
}

template <int M, int N, int K, class F>
DI void lds_mm(LAS unsigned char* lds, int aoff, int lda, int boff, int ldb, F f) {
    const int tid = tid_opaque(), wave = tid >> 6, lane = tid & 63, fr = lane & 15, fq = lane >> 4;
    constexpr int TN = N / 16, NT = (M / 16) * TN;
    constexpr int TB = (NT % 32 == 0) ? 4 : ((NT % 16 == 0) ? 2 : 1);
    for (int tile0 = wave * TB; tile0 < NT; tile0 += 8 * TB) {
        f32x4 acc[TB];
        int ao[TB], bo[TB];
#pragma unroll
        for (int u = 0; u < TB; ++u) {
            const int tile = tile0 + u, tm = tile / TN, tn = tile % TN;
            acc[u] = (f32x4){0.f, 0.f, 0.f, 0.f};
            ao[u] = aoff + (tm * 16 + fr) * lda + fq * 16; bo[u] = boff + (tn * 16 + fr) * ldb + fq * 16;
        }
#pragma unroll
        for (int k0 = 0; k0 < K; k0 += 32) {
            bf16x8 a[TB], b[TB];
#pragma unroll
            for (int u = 0; u < TB; ++u) { a[u] = *(const LAS bf16x8*)(lds + ao[u] + k0 * 2); b[u] = *(const LAS bf16x8*)(lds + bo[u] + k0 * 2); }
#pragma unroll
            for (int u = 0; u < TB; ++u) acc[u] = __builtin_amdgcn_mfma_f32_16x16x32_bf16(a[u], b[u], acc[u], 0, 0, 0);
        }
#pragma unroll
        for (int u = 0; u < TB; ++u) { const int tile = tile0 + u; f((tile / TN) * 16 + fq * 4, (tile % TN) * 16 + fr, acc[u]); }
    }
}

DI void convert_w(const float* W, int K, int N, bf16_t* Bt, int Np, int mode, LAS unsigned char* lds, int bid, int nblk) {
    const int tid = tid_opaque();
    const int tn = Np / 64, tk = K / 64;
    LAS float* tl = (LAS float*)lds;
    for (int tile = bid; tile < tn * tk; tile += nblk) {
        const int n0 = (tile % tn) * 64, k0 = (tile / tn) * 64;
        {
            const int kk = tid >> 3, nn = (tid & 7) * 8, np = n0 + nn;
            int src; bool valid = true;
            if (mode == 1) { const int u = np >> 8, half = (np >> 7) & 1, i = np & 127; src = half * DFF + u * 128 + i; }
            else { src = np; valid = np < N; }
            f32x4 v0 = {0.f, 0.f, 0.f, 0.f}, v1 = {0.f, 0.f, 0.f, 0.f};
            if (valid) { const float* s = W + (size_t)(k0 + kk) * N + src; v0 = *(const f32x4*)s; v1 = *(const f32x4*)(s + 4); }
#pragma unroll
            for (int e = 0; e < 4; ++e) { tl[kk * 65 + nn + e] = v0[e]; tl[kk * 65 + nn + 4 + e] = v1[e]; }
        }
        __syncthreads();
        {
            const int nn = tid >> 3, kk = (tid & 7) * 8;
            u32x4 o;
#pragma unroll
            for (int e = 0; e < 4; ++e) o[e] = pack2(tl[(kk + 2 * e) * 65 + nn], tl[(kk + 2 * e + 1) * 65 + nn]);
            *(u32x4*)(Bt + (size_t)(n0 + nn) * K + k0 + kk) = o;
        }
        __syncthreads();
    }
}

DI void norm_phase(const float* src, const float* src2  , float* copy_to, const float* w, bf16_t* xb, float* yout,
                   int r_begin, int r_end, int wkr, int nwkr, const float* part = nullptr  ,
                   int nsplit = 11, float pscale = 0.5f) {
    const int tid = tid_opaque(); const int lane = tid & 63, gw = wkr * 8 + (tid >> 6), nw = nwkr * 8;
    f32x4 wv[4];
#pragma unroll
    for (int i = 0; i < 4; ++i) wv[i] = *(const f32x4*)(w + i * 256 + lane * 4);
    for (int r = r_begin + gw; r < r_end; r += nw) {
        const float* s = (src2 && r >= T_P) ? src2 + (size_t)(r - T_P) * DM : src + (size_t)r * DM;
        f32x4 v[4]; float ss = 0.f;
#pragma unroll
        for (int i = 0; i < 4; ++i) {
            v[i] = *(const f32x4*)(s + i * 256 + lane * 4);
            if (part && r >= T_P) {
                f32x4 a = {0.f, 0.f, 0.f, 0.f};
                for (int sp = 0; sp < nsplit; ++sp) a += *(const f32x4*)(part + ((size_t)sp * 256 + (r - T_P)) * DM + i * 256 + lane * 4);
                v[i] += a * pscale;
            }
            ss += v[i][0] * v[i][0] + v[i][1] * v[i][1] + v[i][2] * v[i][2] + v[i][3] * v[i][3];
        }
        ss = wave_sum(ss);
        const float rs = rsqrtf(ss * (1.f / DM) + EPS);
#pragma unroll
        for (int i = 0; i < 4; ++i) {
            if (copy_to && (!part || r >= T_P)) *(f32x4*)(copy_to + (size_t)r * DM + i * 256 + lane * 4) = v[i];
            f32x4 y = v[i] * rs * wv[i];
            if (xb) { u32x2 o; o[0] = pack2(y[0], y[1]); o[1] = pack2(y[2], y[3]); *(u32x2*)(xb + (size_t)r * DM + i * 256 + lane * 4) = o; }
            if (yout) *(f32x4*)(yout + (size_t)r * DM + i * 256 + lane * 4) = y;
        }
    }
}

DI int permcol(int b) { return (b & ~31) | (((b >> 2) & 3) << 3) | (((b >> 4) & 1) << 2) | (b & 3); }

template <int C>
DI void gdn_prep(const Params& p, int l, int item, int h, int row0, const float* cache, bool isprompt, float* conv_out, LAS unsigned char* lds, unsigned* flag = nullptr) {
    constexpr int LD = 272;
    constexpr int LC = (C + 8) * 2;
    constexpr int LL = 80;
    constexpr int CRLD = 260 * 4;
    constexpr int KN = 0, QN = KN + C * LD, VV = QN + C * LD, LM = VV + C * LD, LB = LM + C * LL, QK = LB + C * LC, KDT = QK + C * LC, WT = KDT + 128 * LC, UT = WT + 128 * LC,
                  CR = UT + 128 * LC, SC = CR + 16 * CRLD;
    static_assert(SC + 1024 <= LDS_BYTES - 16, "lds");
    const int tid = tid_opaque(), wave = tid >> 6, lane = tid & 63;
    LAS float* sc = (LAS float*)(lds + SC);
    const bf16_t* pb = p.pbuf();
    float cwa[3][4][2];
#pragma unroll
    for (int m = 0; m < 3; ++m)
#pragma unroll
        for (int j = 0; j < 4; ++j) {
            const float* cwp = p.conv_w + (size_t)(l * 4 + j) * 1536 + m * 512 + h * 128 + 2 * lane;
            cwa[m][j][0] = cwp[0]; cwa[m][j][1] = cwp[1];
        }
    bf16_t blr = 0, alr = 0; float dtb = 0.f, alg = 0.f;
    if (wave == 0) {
        if (lane < C) { blr = pb[(size_t)(row0 + lane) * LDP + 2048 + h]; alr = pb[(size_t)(row0 + lane) * LDP + 2052 + h]; }
        dtb = p.dt_bias[l * 4 + h]; alg = p.a_log[l * 4 + h];
    }
    constexpr int RAW = LM, RLD = 784;
    static_assert((C + 3) * RLD <= SC - LM, "raw tile");
    {
        constexpr int NCHK = (C + 3) * 48, NIT = (NCHK + NTHR - 1) / NTHR;
        u32x4 rv[NIT]; f32x4 c0[NIT], c1[NIT];
#pragma unroll
        for (int it = 0; it < NIT; ++it) {
            const int e = tid + it * NTHR, r = e / 48, ch = e % 48, m = ch >> 4, c8 = ch & 15, ti = r - 3;
            const int col = m * 512 + h * 128 + c8 * 8;
            rv[it] = (u32x4){0u, 0u, 0u, 0u}; c0[it] = (f32x4){0.f, 0.f, 0.f, 0.f}; c1[it] = c0[it];
            if (e < NCHK) {
                if (ti >= 0 || (isprompt && row0 + ti >= 0)) rv[it] = *(const u32x4*)(pb + (size_t)(row0 + ti) * LDP + col);
                else if (!isprompt) { c0[it] = *(const f32x4*)(cache + (3 + ti) * 1536 + col); c1[it] = *(const f32x4*)(cache + (3 + ti) * 1536 + col + 4); }
            }
        }
#pragma unroll
        for (int it = 0; it < NIT; ++it) {
            const int e = tid + it * NTHR, r = e / 48, ch = e % 48, ti = r - 3;
            if (e < NCHK) {
                u32x4 v = rv[it];
                if (!(ti >= 0 || (isprompt && row0 + ti >= 0)) && !isprompt) { v[0] = pack2(c0[it][0], c0[it][1]); v[1] = pack2(c0[it][2], c0[it][3]); v[2] = pack2(c1[it][0], c1[it][1]); v[3] = pack2(c1[it][2], c1[it][3]); }
                *(LAS u32x4*)(lds + RAW + r * RLD + ch * 16) = v;
            }
        }
    }
    __syncthreads();
#ifdef PROBE_CONV
    for (int prb = 0; prb < 2; ++prb)
#endif
#pragma unroll
    for (int m = 0; m < 3; ++m) {
        const int col = m * 512 + h * 128 + 2 * lane;
        float cw0[4], cw1[4];
#pragma unroll
        for (int j = 0; j < 4; ++j) { cw0[j] = cwa[m][j][0]; cw1[j] = cwa[m][j][1]; }
        const int dst = (m == 0 ? QN : (m == 1 ? KN : VV));
#pragma unroll
        for (int ii = 0; ii < C / 8; ++ii) {
            const int i = wave + ii * 8;
            float a0 = 0.f, a1 = 0.f, x0 = 0.f, x1 = 0.f;
#pragma unroll
            for (int j = 0; j < 4; ++j) {
                const unsigned u = *(const LAS unsigned*)(lds + RAW + (i + j) * RLD + m * 256 + lane * 4);
                x0 = lo2f(u); x1 = hi2f(u);
                a0 += cw0[j] * x0; a1 += cw1[j] * x1;
            }
            if (conv_out && i >= C - 3) { conv_out[(i - (C - 3)) * 1536 + col] = x0; conv_out[(i - (C - 3)) * 1536 + col + 1] = x1; }
            float s0 = silu_f(a0), s1 = silu_f(a1);
            if (m < 2) {
                const float ss = wave_sum(s0 * s0 + s1 * s1);
                const float r = rsqrtf(ss + EPS) * (m == 0 ? 0.08838834764831845f : 1.f);
                s0 *= r; s1 *= r;
            }
            *(LAS unsigned*)(lds + dst + i * LD + lane * 4) = pack2(s0, s1);
        }
    }
    if (wave == 0) {
        float gi = 0.f, bi = 0.f;
        if (lane < C) {
            const float bl = bf2f(blr), al = bf2f(alr);
            bi = __builtin_amdgcn_rcpf(1.f + __expf(-bl));
            const float x = al + dtb;
            const float sp = fmaxf(x, 0.f) + __logf(1.f + __expf(-fabsf(x)));
            gi = -__expf(alg) * sp;
        }
        float G = gi;
#pragma unroll
        for (int o = 1; o < 64; o <<= 1) { const float t = __shfl_up(G, o); if (lane >= o) G += t; }
        const float Gl = __shfl(G, C - 1);
        if (lane < C) { sc[lane] = G; sc[64 + lane] = bi; sc[128 + lane] = __expf(G); sc[192 + lane] = __expf(Gl - G); }
        if (lane == 0) p.gtot()[item] = __expf(Gl);
    }
    __syncthreads();
    lds_mm<C, C, 128>(lds, KN, LD, KN, LD, [&](int i0, int j, f32x4 v) {
        const float Gj = sc[j];
        f32x4 o;
#pragma unroll
        for (int e = 0; e < 4; ++e) { const int i = i0 + e; o[e] = (i > j) ? v[e] * __expf(sc[i] - Gj) * sc[64 + i] : 0.f; }
#pragma unroll
        for (int e = 0; e < 4; ++e) *(LAS bf16_t*)(lds + LB + (i0 + e) * LC + j * 2) = f2bf(o[e]);
        if ((i0 >> 4) == (j >> 4)) *(LAS f32x4*)(lds + LM + j * LL + (i0 & 15) * 4) = o;
    });
    lds_mm<C, C, 128>(lds, KN, LD, QN, LD, [&](int j0, int i, f32x4 v) {
        const float Gi = sc[i];
        float o[4];
#pragma unroll
        for (int e = 0; e < 4; ++e) { const int j = j0 + e; o[e] = (i >= j) ? v[e] * __expf(Gi - sc[j]) : 0.f; }
        u32x2 w; w[0] = pack2(o[0], o[1]); w[1] = pack2(o[2], o[3]);
        *(LAS u32x2*)(lds + QK + i * LC + j0 * 2) = w;
    });
    for (int e = tid; e < C * 128; e += NTHR) {
        const int c = e >> 7, a = e & 127;
        const float kv = bf2f(*(const LAS bf16_t*)(lds + KN + c * LD + a * 2));
        *(LAS bf16_t*)(lds + KDT + a * LC + c * 2) = f2bf(kv * sc[192 + c]);
    }
    __syncthreads();
    {
        typedef short s16x4 __attribute__((ext_vector_type(4)));
        const int fr = lane & 15, fq = lane >> 4;
        const bool isU = tid < 128; const int cc = tid & 127;
        const int srcb = (isU ? VV : KN) + cc * 2;
        const int dst = (isU ? UT : WT) + cc * LC;
#pragma unroll 1
        for (int ib = 0; ib < C / 16; ++ib) {
            if (ib > 0) {
#pragma unroll
                for (int t = 0; t < 2; ++t) {
                    const int col = (wave * 2 + t) * 16 + fr;
                    const int xrow = (col < 128 ? UT + col * LC : WT + (col - 128) * LC);
                    f32x4 acc = {0.f, 0.f, 0.f, 0.f};
#pragma unroll 1
                    for (int kb = 0; kb < ib; ++kb) {
                        const s16x4 a = *(const LAS s16x4*)(lds + LB + (ib * 16 + fr) * LC + (kb * 16 + 4 * fq) * 2);
                        const s16x4 bb = *(const LAS s16x4*)(lds + xrow + (kb * 16 + 4 * fq) * 2);
                        acc = __builtin_amdgcn_mfma_f32_16x16x16bf16_1k(a, bb, acc, 0, 0, 0);
                    }
#pragma unroll
                    for (int e = 0; e < 4; ++e) *(LAS float*)(lds + CR + (4 * fq + e) * CRLD + col * 4) = acc[e];
                }
                __syncthreads();
            }
            if (tid < 256) {
                float acc[16];
#pragma unroll
                for (int r = 0; r < 16; ++r) {
                    const int i = ib * 16 + r;
                    const float src = bf2f(*(const LAS bf16_t*)(lds + srcb + i * LD));
                    acc[r] = isU ? src * sc[64 + i] : src * sc[64 + i] * sc[128 + i];
                    if (ib > 0) acc[r] -= *(const LAS float*)(lds + CR + r * CRLD + tid * 4);
                }
#pragma unroll
                for (int r2 = 0; r2 < 15; ++r2) {
                    f32x4 lq[4];
#pragma unroll
                    for (int q = 0; q < 4; ++q) lq[q] = *(const LAS f32x4*)(lds + LM + (ib * 16 + r2) * LL + q * 16);
#pragma unroll
                    for (int r = r2 + 1; r < 16; ++r) acc[r] -= lq[r >> 2][r & 3] * acc[r2];
                }
#pragma unroll
                for (int r = 0; r < 16; r += 2) *(LAS unsigned*)(lds + dst + (ib * 16 + r) * 2) = pack2(acc[r], acc[r + 1]);
            }
            __syncthreads();
        }
    }
#ifdef PROBE_PROD
    for (int prb = 0; prb < 2; ++prb) {
#endif
    bf16_t* An = p.Aneg() + (size_t)item * 16384;
    bf16_t* Bt = p.BT() + (size_t)item * 16384;
    bf16_t* Qp = p.Qp() + (size_t)item * 8192;
    bf16_t* Op = p.Op() + (size_t)item * 8192;
    lds_mm<128, 128, C>(lds, WT, LC, KDT, LC, [&](int b0, int a, f32x4 v) {
        u32x2 w; w[0] = pack2(-v[0], -v[1]); w[1] = pack2(-v[2], -v[3]);
        *(u32x2*)(An + a * 128 + permcol(b0)) = w;
    });
    lds_mm<128, 128, C>(lds, KDT, LC, UT, LC, [&](int a0, int vv, f32x4 v) {
        u32x2 w; w[0] = pack2(v[0], v[1]); w[1] = pack2(v[2], v[3]);
        *(u32x2*)(Bt + vv * 128 + a0) = w;
    });
    lds_mm<128, C, C>(lds, WT, LC, QK, LC, [&](int b0, int i, f32x4 v) {
        const u32x2 q = *(const LAS u32x2*)(lds + QN + i * LD + b0 * 2);
        const float eg = sc[128 + i];
        u32x2 w; w[0] = pack2(lo2f(q[0]) * eg - v[0], hi2f(q[0]) * eg - v[1]); w[1] = pack2(lo2f(q[1]) * eg - v[2], hi2f(q[1]) * eg - v[3]);
        *(u32x2*)(Qp + i * 128 + b0) = w;
    });
    lds_mm<128, C, C>(lds, UT, LC, QK, LC, [&](int v0, int i, f32x4 v) {
        u32x2 w; w[0] = pack2(v[0], v[1]); w[1] = pack2(v[2], v[3]);
        *(u32x2*)(Op + i * 128 + v0) = w;
    });
#ifdef PROBE_PROD
    }
#endif
    if (flag) {
        asm volatile("s_waitcnt vmcnt(0)" ::: "memory");
        __syncthreads();
        if (tid == 0) {
            __builtin_amdgcn_fence(__ATOMIC_RELEASE, "agent");
            asm volatile("s_waitcnt vmcnt(0)" ::: "memory");
            __hip_atomic_store(flag, 1u, __ATOMIC_RELAXED, __HIP_MEMORY_SCOPE_AGENT);
        }
    } else {
        __syncthreads();
    }
}

DI void rope16(float (&x)[16], int pos) {
#pragma unroll
    for (int i = 0; i < 8; ++i) {
        const float inv = exp2f(-(float)i * 2.3664460711f);
        const float ang = (float)pos * inv;
        const float k = rintf(ang * 0.15915494309189535f);
        float r = fmaf(-k, 6.2831854820251465f, ang); r = fmaf(-k, -1.7484555314695172e-07f, r);
        const float cs = __cosf(r), sn = __sinf(r);
        const float x1 = x[i], x2 = x[i + 8];
        x[i] = x1 * cs - x2 * sn; x[i + 8] = x2 * cs + x1 * sn;
    }
}

template <int NQ, int NK>
DI void swa_item(const Params& p, int l, int kvh, int qrow0, int qpos0, int krow0  , int kpos0, int ncache,
                 const float* ck, const float* cv, float* outk, float* outv, int out_from  , LAS unsigned char* lds, int g0 = 0, int g1 = 4) {
    constexpr int LK = 144, LVT = (NK + 8) * 2, LQ = 144, LS = (NK + 4) * 4;
    constexpr int KL = 0, VT = KL + NK * LK, QL = VT + 64 * LVT, SCo = QL + 4 * NQ * LQ;
    static_assert(SCo + NQ * LS <= LDS_BYTES, "lds");
    const int tid = tid_opaque(), wave = tid >> 6, lane = tid & 63;
    const bf16_t* pb = p.pbuf();
    const float sk0 = p.sinks[l * 8 + kvh * 4], sk1 = p.sinks[l * 8 + kvh * 4 + 1], sk2 = p.sinks[l * 8 + kvh * 4 + 2], sk3 = p.sinks[l * 8 + kvh * 4 + 3];
    constexpr int NQI = 4 * NQ * 4 / NTHR, NKI = (NK * 4 + NTHR - 1) / NTHR;
    u32x4 qr[NQI][2], kr[NKI][2], vr[NKI][2];
#pragma unroll
    for (int it = 0; it < NQI; ++it) {
        const int e = tid + it * NTHR, g = e / (NQ * 4), i = (e >> 2) % NQ, part = e & 3;
        const bf16_t* sp = pb + (size_t)(qrow0 + i) * LDP + 2056 + (kvh * 4 + g) * 64 + part * 16;
        qr[it][0] = *(const u32x4*)sp; qr[it][1] = *(const u32x4*)(sp + 8);
    }
#pragma unroll
    for (int it = 0; it < NKI; ++it) {
        const int e = tid + it * NTHR, j = e >> 2, part = e & 3, prow = krow0 + j;
        kr[it][0] = (u32x4){0u, 0u, 0u, 0u}; kr[it][1] = kr[it][0]; vr[it][0] = kr[it][0]; vr[it][1] = kr[it][0];
        if (e < NK * 4 && j >= ncache && prow >= 0) {
            const bf16_t* sk = pb + (size_t)prow * LDP + 2568 + kvh * 64 + part * 16; const bf16_t* sv = pb + (size_t)prow * LDP + 2696 + kvh * 64 + part * 16;
            kr[it][0] = *(const u32x4*)sk; kr[it][1] = *(const u32x4*)(sk + 8); vr[it][0] = *(const u32x4*)sv; vr[it][1] = *(const u32x4*)(sv + 8);
        }
    }
#pragma unroll
    for (int it = 0; it < NQI; ++it) {
        const int e = tid + it * NTHR, g = e / (NQ * 4), i = (e >> 2) % NQ, part = e & 3;
        float qx[16];
#pragma unroll
        for (int q = 0; q < 4; ++q) { qx[2 * q] = lo2f(qr[it][0][q]); qx[2 * q + 1] = hi2f(qr[it][0][q]); qx[8 + 2 * q] = lo2f(qr[it][1][q]); qx[8 + 2 * q + 1] = hi2f(qr[it][1][q]); }
        if (part == 0) rope16(qx, qpos0 + i);
#pragma unroll
        for (int d = 0; d < 16; d += 2) *(LAS unsigned*)(lds + QL + (g * NQ + i) * LQ + (part * 16 + d) * 2) = pack2(qx[d], qx[d + 1]);
    }
#pragma unroll
    for (int it = 0; it < NKI; ++it) {
        const int e = tid + it * NTHR, j = e >> 2, part = e & 3;
        if (e < NK * 4) {
            float kx[16], vx[16];
            if (j < ncache) {
                const float* s = ck + ((size_t)j * 2 + kvh) * 64 + part * 16; const float* s2 = cv + ((size_t)j * 2 + kvh) * 64 + part * 16;
#pragma unroll
                for (int d = 0; d < 16; d += 4) { const f32x4 a4 = *(const f32x4*)(s + d), b4 = *(const f32x4*)(s2 + d);
#pragma unroll
                    for (int q = 0; q < 4; ++q) { kx[d + q] = a4[q]; vx[d + q] = b4[q]; } }
            } else {
#pragma unroll
                for (int q = 0; q < 4; ++q) { kx[2 * q] = lo2f(kr[it][0][q]); kx[2 * q + 1] = hi2f(kr[it][0][q]); kx[8 + 2 * q] = lo2f(kr[it][1][q]); kx[8 + 2 * q + 1] = hi2f(kr[it][1][q]);
                                              vx[2 * q] = lo2f(vr[it][0][q]); vx[2 * q + 1] = hi2f(vr[it][0][q]); vx[8 + 2 * q] = lo2f(vr[it][1][q]); vx[8 + 2 * q + 1] = hi2f(vr[it][1][q]); }
                if (part == 0) rope16(kx, kpos0 + j);
            }
            if (outk && j >= out_from) {
                float* ok = outk + ((size_t)(j - out_from) * 2 + kvh) * 64 + part * 16; float* ov = outv + ((size_t)(j - out_from) * 2 + kvh) * 64 + part * 16;
#pragma unroll
                for (int d = 0; d < 16; d += 4) { *(f32x4*)(ok + d) = (f32x4){kx[d], kx[d + 1], kx[d + 2], kx[d + 3]}; *(f32x4*)(ov + d) = (f32x4){vx[d], vx[d + 1], vx[d + 2], vx[d + 3]}; }
            }
#pragma unroll
            for (int d = 0; d < 16; d += 2) *(LAS unsigned*)(lds + KL + j * LK + (part * 16 + d) * 2) = pack2(kx[d], kx[d + 1]);
#pragma unroll
            for (int d = 0; d < 16; ++d) *(LAS bf16_t*)(lds + VT + (part * 16 + d) * LVT + j * 2) = f2bf(vx[d]);
        }
    }
    __syncthreads();
    for (int g = g0; g < g1; ++g) {
        const int head = kvh * 4 + g;
        lds_mm<NK, NQ, 64>(lds, KL, LK, QL + g * NQ * LQ, LQ, [&](int j0, int i, f32x4 v) {
            f32x4 o;
#pragma unroll
            for (int e = 0; e < 4; ++e) { const int j = j0 + e; o[e] = (j >= ncache && krow0 + j < 0) ? -INFINITY : v[e] * 0.125f; }
            *(LAS f32x4*)(lds + SCo + i * LS + j0 * 4) = o;
        });
        __syncthreads();
        const float sk = g == 0 ? sk0 : (g == 1 ? sk1 : (g == 2 ? sk2 : sk3));
        for (int i = wave; i < NQ; i += 8) {
            float sv[(NK + 63) / 64]; float mx = sk;
#pragma unroll
            for (int t = 0; t < (NK + 63) / 64; ++t) { const int j = lane + 64 * t; sv[t] = (j < NK) ? *(const LAS float*)(lds + SCo + i * LS + j * 4) : -INFINITY; mx = fmaxf(mx, sv[t]); }
            mx = wave_max(mx);
            float sum = 0.f;
#pragma unroll
            for (int t = 0; t < (NK + 63) / 64; ++t) { sv[t] = __expf(sv[t] - mx); sum += sv[t]; }
            sum = wave_sum(sum) + __expf(sk - mx);
            const float inv = __builtin_amdgcn_rcpf(sum);
#pragma unroll
            for (int t = 0; t < (NK + 63) / 64; ++t) { const int j = lane + 64 * t; if (j < NK) *(LAS bf16_t*)(lds + SCo + i * LS + j * 2) = f2bf(sv[t] * inv); }
        }
        __syncthreads();
        lds_mm<64, NQ, NK>(lds, VT, LVT, SCo, LS, [&](int d0, int i, f32x4 v) {
            u32x2 w; w[0] = pack2(v[0], v[1]); w[1] = pack2(v[2], v[3]);
            *(u32x2*)(p.xb() + (size_t)(qrow0 + i) * DM + 512 + head * 64 + d0) = w;
        });
        __syncthreads();
    }
}

DI void scan_run(const Params& p, LAS unsigned char* lds, int item0, int istride, const float* S0, float* Sout, int slice, unsigned* flags  ) {
    const int tid = tid_opaque(), wave = tid >> 6, lane = tid & 63, fr = lane & 15, fq = lane >> 4;
    constexpr int BUF = 128 * 272, SLOT = 2 * BUF, D = 6, n = NCH;
    const bool cw = wave < 4;
    const int tl = tid & 255;
    auto gload = [&](u32x4 (&R)[8], int step) {
        const bf16_t* src = p.Aneg() + (size_t)(item0 + step * istride) * 16384;
#pragma unroll
        for (int i = 0; i < 8; ++i) { const int q = tl + 256 * i; R[i] = *(const u32x4*)(src + (q >> 4) * 128 + (q & 15) * 8); }
    };
    auto lstore = [&](const u32x4 (&R)[8], int buf) {
#pragma unroll
        for (int i = 0; i < 8; ++i) { const int q = tl + 256 * i; *(LAS u32x4*)(lds + buf * BUF + (q >> 4) * 272 + (q & 15) * 16) = R[i]; }
    };
    const size_t lofs = (size_t)(slice * 16 + fr) * 128 + 4 * fq + 32 * (wave & 3);
    f32x4 S[2];
#pragma unroll
    for (int t = 0; t < 2; ++t) {
        if (S0) { for (int j = 0; j < 4; ++j) S[t][j] = S0[(32 * (wave & 3) + 16 * t + 4 * fq + j) * 128 + slice * 16 + fr]; }
        else { float z = 0.f; asm volatile("" : "+v"(z)); S[t] = (f32x4){z, z, z, z}; }
    }
    auto publish = [&](int sb, int step) {
        u32x4 w4; w4[0] = pack2(S[0][0], S[0][1]); w4[1] = pack2(S[0][2], S[0][3]); w4[2] = pack2(S[1][0], S[1][1]); w4[3] = pack2(S[1][2], S[1][3]);
        *(LAS u32x4*)(lds + SLOT + ((sb * 4 + wave) * 64 + lane) * 16) = w4;
        const size_t it = step < n ? (size_t)(item0 + step * istride) : (size_t)N_ITEM;
        bf16_t* st = p.ST() + it * 16384 + lofs;
        u32x2 lo; lo[0] = w4[0]; lo[1] = w4[1]; u32x2 hi; hi[0] = w4[2]; hi[1] = w4[3];
        *(u32x2*)st = lo; *(u32x2*)(st + 16) = hi;
    };
    auto loadB = [&](u32x2 (&B)[2], float& g, int step) {
        const size_t it = (size_t)(item0 + step * istride);
        g = p.gtot()[it];
        B[0] = *(const u32x2*)(p.BT() + it * 16384 + lofs); B[1] = *(const u32x2*)(p.BT() + it * 16384 + lofs + 16);
    };
    auto compute = [&](const u32x2 (&B)[2], float g, int step, int buf) {
        const int sbc = step & 1;
        bf16x8 Sb[4], Af[4][2];
#pragma unroll
        for (int s = 0; s < 4; ++s) Sb[s] = *(const LAS bf16x8*)(lds + SLOT + ((sbc * 4 + s) * 64 + lane) * 16);
#pragma unroll
        for (int s = 0; s < 4; ++s)
#pragma unroll
            for (int t = 0; t < 2; ++t) Af[s][t] = *(const LAS bf16x8*)(lds + buf * BUF + (16 * (2 * wave + t) + fr) * 272 + (32 * s + 8 * fq) * 2);
        f32x4 acc[2];
#pragma unroll
        for (int t = 0; t < 2; ++t) { acc[t][0] = g * S[t][0] + lo2f(B[t][0]); acc[t][1] = g * S[t][1] + hi2f(B[t][0]); acc[t][2] = g * S[t][2] + lo2f(B[t][1]); acc[t][3] = g * S[t][3] + hi2f(B[t][1]); }
        asm volatile("s_waitcnt lgkmcnt(0)" ::: "memory");
#pragma unroll
        for (int s = 0; s < 4; ++s)
#pragma unroll
            for (int t = 0; t < 2; ++t) acc[t] = __builtin_amdgcn_mfma_f32_16x16x32_bf16(Af[s][t], Sb[s], acc[t], 0, 0, 0);
        S[0] = acc[0]; S[1] = acc[1];
        publish(sbc ^ 1, step + 1);
    };
    int ready = 0;
    auto ensure = [&](int need) {
        while (ready < need) {
            unsigned sp = 0;
            for (;;) {
                const int c = ready + (lane & 31);
                const unsigned f = c < n ? __hip_atomic_load(flags + (size_t)c * istride, __ATOMIC_RELAXED, __HIP_MEMORY_SCOPE_AGENT) : 1u;
                if ((__builtin_amdgcn_ballot_w64(f != 0u) & 0xffffffffull) == 0xffffffffull) break;
                __builtin_amdgcn_s_sleep(2);
                if (++sp > (1u << 22)) break;
            }
            __builtin_amdgcn_fence(__ATOMIC_ACQUIRE, "agent");
            asm volatile("s_waitcnt vmcnt(0)" ::: "memory");
            ready += 32;
        }
    };
    if (wave == 4) ensure(D + 3 < n ? D + 3 : n);
    __syncthreads();
    if (cw) {
        u32x2 Bv[D][2]; float gv[D];
#pragma unroll
        for (int k = 0; k < D; ++k) loadB(Bv[k], gv[k], k);
        publish(0, 0);
        lds_barrier();
        int c0 = 0;
        for (; c0 + D <= n; c0 += D) {
#pragma unroll
            for (int k = 0; k < D; ++k) { const int c = c0 + k; compute(Bv[k], gv[k], c, c & 1); loadB(Bv[k], gv[k], c + D < n ? c + D : n - 1); lds_barrier(); }
        }
#pragma unroll
        for (int k = 0; k < n % D; ++k) { const int c = c0 + k; compute(Bv[k], gv[k], c, c & 1); lds_barrier(); }
    } else {
        u32x4 RR[D][8];
        { u32x4 Rt[8]; gload(Rt, 0); lstore(Rt, 0); }
#pragma unroll
        for (int k = 0; k < D; ++k) gload(RR[(k + 1) % D], k + 1);
        lds_barrier();
        int c0 = 0;
        for (; c0 + D <= n; c0 += D) {
#pragma unroll
            for (int k = 0; k < D; ++k) {
                const int c = c0 + k;
                lstore(RR[(k + 1) % D], (c + 1) & 1); gload(RR[(k + 1) % D], c + 1 + D < n ? c + 1 + D : n - 1);
                if (wave == 4) ensure(c + D + 4 < n ? c + D + 4 : n);
                lds_barrier();
            }
        }
#pragma unroll
        for (int k = 0; k < n % D; ++k) { const int c = c0 + k; lstore(RR[(k + 1) % D], (c + 1) & 1); lds_barrier(); }
    }
    __syncthreads();
    if (cw) {
#pragma unroll
        for (int t = 0; t < 2; ++t)
#pragma unroll
            for (int j = 0; j < 4; ++j) Sout[(32 * wave + 16 * t + 4 * fq + j) * 128 + slice * 16 + fr] = S[t][j];
    }
}

DI void scan_single(const Params& p, LAS unsigned char* lds, int item, const float* S0, float* Sout) {
    constexpr int LD = 272, AL = 0, S0T = AL + 128 * LD;
    const int tid = tid_opaque();
    const bf16_t* An = p.Aneg() + (size_t)item * 16384;
    bf16_t* ST = p.ST() + (size_t)item * 16384;
    {
        u32x4 av[4]; f32x4 sv[8];
#pragma unroll
        for (int i = 0; i < 4; ++i) { const int q = tid + NTHR * i; av[i] = *(const u32x4*)(An + (q >> 4) * 128 + (q & 15) * 8); }
#pragma unroll
        for (int i = 0; i < 8; ++i) { const int q = tid + NTHR * i; sv[i] = *(const f32x4*)(S0 + (q >> 5) * 128 + (q & 31) * 4); }
#pragma unroll
        for (int i = 0; i < 4; ++i) { const int q = tid + NTHR * i; *(LAS u32x4*)(lds + AL + (q >> 4) * LD + (q & 15) * 16) = av[i]; }
#pragma unroll
        for (int i = 0; i < 8; ++i) {
            const int q = tid + NTHR * i, k = q >> 5, v0 = (q & 31) * 4, pk = permcol(k);
#pragma unroll
            for (int e = 0; e < 4; ++e) { const bf16_t b = f2bf(sv[i][e]); *(LAS bf16_t*)(lds + S0T + (v0 + e) * LD + pk * 2) = b; ST[(v0 + e) * 128 + k] = b; }
        }
    }
    __syncthreads();
    const float g = p.gtot()[item];
    const bf16_t* Bt = p.BT() + (size_t)item * 16384;
    lds_mm<128, 128, 128>(lds, AL, LD, S0T, LD, [&](int a0, int v, f32x4 c) {
        const u32x2 b = *(const u32x2*)(Bt + v * 128 + a0);
        const float bb[4] = {lo2f(b[0]), hi2f(b[0]), lo2f(b[1]), hi2f(b[1])};
#pragma unroll
        for (int e = 0; e < 4; ++e) Sout[(a0 + e) * 128 + v] = g * S0[(a0 + e) * 128 + v] + bb[e] + c[e];
    });
    __syncthreads();
}

template <int C>
DI void gdn_out(const Params& p, int l, int item, int h, int row0, LAS unsigned char* lds) {
    constexpr int LD = 272, QP = 0, STL = QP + C * LD, OPL = STL + 128 * LD, ZL = OPL + C * LD, OB = ZL + C * LD, LO = 132 * 4;
    static_assert(OB + C * LO <= LDS_BYTES, "lds");
    const int tid = tid_opaque(), wave = tid >> 6, lane = tid & 63;
    const bf16_t* Qp = p.Qp() + (size_t)item * 8192; const bf16_t* ST = p.ST() + (size_t)item * 16384; const bf16_t* Op = p.Op() + (size_t)item * 8192;
    const float gw0 = p.gnorm_w[l * 128 + 2 * lane], gw1 = p.gnorm_w[l * 128 + 2 * lane + 1];
    {
        constexpr int N1 = C * 16 / NTHR;
        u32x4 q[N1], o[N1], z[N1], st[4];
#pragma unroll
        for (int it = 0; it < N1; ++it) { const int e = tid + it * NTHR, r = e >> 4, c8 = e & 15;
            q[it] = *(const u32x4*)(Qp + r * 128 + c8 * 8); o[it] = *(const u32x4*)(Op + r * 128 + c8 * 8);
            z[it] = *(const u32x4*)(p.pbuf() + (size_t)(row0 + r) * LDP + 1536 + h * 128 + c8 * 8); }
#pragma unroll
        for (int it = 0; it < 4; ++it) { const int e = tid + it * NTHR, r = e >> 4, c8 = e & 15; st[it] = *(const u32x4*)(ST + r * 128 + c8 * 8); }
#pragma unroll
        for (int it = 0; it < N1; ++it) { const int e = tid + it * NTHR, r = e >> 4, c8 = e & 15;
            *(LAS u32x4*)(lds + QP + r * LD + c8 * 16) = q[it]; *(LAS u32x4*)(lds + OPL + r * LD + c8 * 16) = o[it]; *(LAS u32x4*)(lds + ZL + r * LD + c8 * 16) = z[it]; }
#pragma unroll
        for (int it = 0; it < 4; ++it) { const int e = tid + it * NTHR, r = e >> 4, c8 = e & 15; *(LAS u32x4*)(lds + STL + r * LD + c8 * 16) = st[it]; }
    }
    __syncthreads();
    lds_mm<128, C, 128>(lds, STL, LD, QP, LD, [&](int v0, int i, f32x4 v) {
        const u32x2 o = *(const LAS u32x2*)(lds + OPL + i * LD + v0 * 2);
        f32x4 r; r[0] = v[0] + lo2f(o[0]); r[1] = v[1] + hi2f(o[0]); r[2] = v[2] + lo2f(o[1]); r[3] = v[3] + hi2f(o[1]);
        *(LAS f32x4*)(lds + OB + i * LO + v0 * 4) = r;
    });
    __syncthreads();
    for (int i = wave; i < C; i += 8) {
        const float o0 = *(const LAS float*)(lds + OB + i * LO + lane * 8), o1 = *(const LAS float*)(lds + OB + i * LO + lane * 8 + 4);
        const float ss = wave_sum(o0 * o0 + o1 * o1);
        const float r = rsqrtf(ss * (1.f / 128.f) + EPS);
        const unsigned zu = *(const LAS unsigned*)(lds + ZL + i * LD + lane * 4);
        const float y0 = o0 * r * gw0 * silu_f(lo2f(zu)), y1 = o1 * r * gw1 * silu_f(hi2f(zu));
        *(unsigned*)(p.xb() + (size_t)(row0 + i) * DM + h * 128 + 2 * lane) = pack2(y0, y1);
    }
    __syncthreads();
}

#if defined(DUP_PHASE) && (DUP_PHASE == 2 || DUP_PHASE == 11)
#define HALFSCALE(s) ((s) == DUP_PHASE ? (rep ? 0.5f : 0.0f) : 0.5f)
#else
#define HALFSCALE(s) 0.5f
#endif
#if defined(DUP_PHASE) && DUP_PHASE == 8
#define ONESCALE 0.5f
#else
#define ONESCALE 1.0f
#endif
constexpr int PH_PER_LAYER = 11;
constexpr int N_PHASE = DEPTH * PH_PER_LAYER + 1;

DI void sample_stage_a(const Params& p, int l, LAS unsigned char* lds, int tr, unsigned& tgt) {
    unsigned* cnt = p.bar() + XCD_BAR_WORDS;
    { pg8::SplitKOrder S{4, 11, 256, TEAM, tr};
      pg8::gemm_phase(lds, pg8::Gemm{p.act_s(), p.w_ffout1(), 256, DM, 256, DFF}, S, pg8::EpiPartial{p.part()}); }
    team_barrier(cnt, tgt);
    norm_phase(p.xres(), nullptr, p.xres(), p.norm_mix + l * DM, p.xb(), nullptr, T_P, T_ALL, tr, TEAM, p.part());
    team_barrier(cnt, tgt);
    { pg8::StaticOrder S; S.init(256, LDP, TEAM, tr);
      pg8::gemm_phase(lds, pg8::Gemm{p.xb() + (size_t)T_P * DM, p.w_mixin(), 256, LDP, DM, DM}, S, pg8::EpiBf16{p.pbuf(), LDP, T_P}); }
}
DI void sample_stage_b(const Params& p, int l, LAS unsigned char* lds, int tr, unsigned& tgt) {
    unsigned* cnt = p.bar() + XCD_BAR_WORDS;
#ifdef PROBE_TEAM_MIX
    for (int prb = 0; prb < 2; ++prb) {
#endif
    {
        const int sidx = tr >> 2, h = tr & 3;
        gdn_prep<32>(p, l, NCH * 4 + tr, h, T_P + sidx * 32, p.cache_conv + (size_t)(l * 8 + sidx) * 3 * 1536, false, p.out + O_CONVS + (size_t)(l * 8 + sidx) * 3 * 1536, lds);
        {
            const int s2 = tr >> 2, kvh = (tr >> 1) & 1, gh = (tr & 1) * 2;
            swa_item<32, 160>(p, l, kvh, T_P + s2 * 32, 4096, T_P + s2 * 32 - 128, 4096 - 128, 128,
                              p.cache_k + (size_t)(l * 8 + s2) * 128 * 128, p.cache_v + (size_t)(l * 8 + s2) * 128 * 128,
                              p.out + O_KS + (size_t)(l * 8 + s2) * 128 * 128, p.out + O_VS + (size_t)(l * 8 + s2) * 128 * 128, 32, lds, gh, gh + 2);
        }
    }
    asm volatile("s_waitcnt vmcnt(0)" ::: "memory"); __syncthreads();
    scan_single(p, lds, NCH * 4 + tr, p.state_delta + (size_t)(l * 32 + tr) * 16384, p.out + O_DELTAS + (size_t)(l * 32 + tr) * 16384);
    asm volatile("s_waitcnt vmcnt(0)" ::: "memory"); __syncthreads();
    gdn_out<32>(p, l, NCH * 4 + tr, tr & 3, T_P + (tr >> 2) * 32, lds);
#ifdef PROBE_TEAM_MIX
    }
#endif
    team_barrier(cnt, tgt);
    { pg8::SplitKOrder SK{4, 4, 256, TEAM, tr};
      pg8::gemm_phase(lds, pg8::Gemm{p.xb() + (size_t)T_P * DM, p.w_mixout(), 256, DM, 256, DM}, SK, pg8::EpiPartial{p.part()}); }
    team_barrier(cnt, tgt);
    norm_phase(p.xres(), nullptr, p.xres(), p.norm_ff2 + l * DM, p.xb(), nullptr, T_P, T_ALL, tr, TEAM, p.part(), 4, 1.0f);
}

__global__ void __launch_bounds__(NTHR) fwd_megakernel(Params p) {
    extern __shared__ __attribute__((aligned(16))) unsigned char shm[];
    LAS unsigned char* lds = (LAS unsigned char*)shm;
    cg::grid_group grid = cg::this_grid();
    const int bid = blockIdx.x, nblk = gridDim.x;
    volatile LAS unsigned* xst = (volatile LAS unsigned*)(lds + LDS_BYTES - 16);
    if (threadIdx.x == 0) { xst[0] = 0u; xst[1] = 0u; }
    __syncthreads();
    const XcdBarrier xbar = xcd_barrier_post(p.bar(), xst);
    const int nwk = nblk - TEAM;
    const bool team = bid >= nwk; const int tr = bid - nwk;
    unsigned tgt = 0u;
    LAS unsigned char* const lds0 = lds;
    for (int ph = p.phase_lo; ph <= p.phase_hi; ++ph) {
        if (ph == p.phase_lo + 1) grid.sync(); else if (ph > p.phase_lo) xcd_barrier(xbar);
        { unsigned lv = (unsigned)(size_t)lds0; asm volatile("" : "+s"(lv)); lds = (LAS unsigned char*)(size_t)lv; }
#ifdef DUP_PHASE
        for (int rep = 0; rep < ((ph % PH_PER_LAYER) == DUP_PHASE && ph != N_PHASE - 1 ? 2 : 1); ++rep) {
        if (rep) xcd_barrier(xbar);
#endif
        if (ph == N_PHASE - 1) { norm_phase(p.xres(), nullptr, nullptr, p.norm_final, nullptr, p.out + O_Y, 0, T_ALL, bid, nblk, p.part()); break; }
        const int l = ph / PH_PER_LAYER, s = ph % PH_PER_LAYER;
        switch (s) {
        case 0: {
            if (l == 0) {
                convert_w(p.ff1_w_in, DM, 2 * DFF, p.w_ffin1(), 2 * DFF, 1, lds, bid, nblk);
                convert_w(p.ff1_w_out, DFF, DM, p.w_ffout1(), DM, 0, lds, bid, nblk);
                convert_w(p.w_mix_in, DM, DIN, p.w_mixin(), LDP, 0, lds, bid, nblk);
            }
            convert_w(p.w_mix_out + (size_t)l * DM * DM, DM, DM, p.w_mixout(), DM, 0, lds, bid, nblk);
            convert_w(p.ff2_w_in + (size_t)l * DM * 2 * DFF, DM, 2 * DFF, p.w_ffin2(), 2 * DFF, 1, lds, bid, nblk);
            convert_w(p.ff2_w_out + (size_t)l * DFF * DM, DFF, DM, p.w_ffout2(), DM, 0, lds, bid, nblk);
            if (l == 0) norm_phase(p.x_prompt, p.x_sample, p.xres(), p.norm_ff1, p.xb(), nullptr, 0, T_ALL, bid, nblk);
            else norm_phase(p.xres(), nullptr, p.xres(), p.norm_ff1 + l * DM, p.xb(), nullptr, 0, T_ALL, bid, nblk, p.part());
        } break;
        case 1: case 9: {
            const int Mrows = T_ALL;
            pg8::StaticOrder S; S.init(Mrows, 2 * DFF, nblk, bid);
            pg8::gemm_phase(lds, pg8::Gemm{p.xb(), s == 1 ? p.w_ffin1() : p.w_ffin2(), Mrows, 2 * DFF, DM, DM}, S, pg8::EpiSwiglu{p.act(), 0, p.act_s()});
        } break;
        case 2: case 10: {
            pg8::StaticOrder S; S.init(T_P, DM, nblk, bid);
#ifdef PROBE_FFOUT
            for (int prb = 0; prb < 2; ++prb) {
                if (prb) xcd_barrier(xbar);
                pg8::gemm_phase(lds, pg8::Gemm{p.act(), s == 2 ? p.w_ffout1() : p.w_ffout2(), T_P, DM, DFF, DFF}, S, pg8::EpiResid{p.xres(), 0.25f, 0});
            }
#else
            pg8::gemm_phase(lds, pg8::Gemm{p.act(), s == 2 ? p.w_ffout1() : p.w_ffout2(), T_P, DM, DFF, DFF}, S, pg8::EpiResid{p.xres(), 0.5f, 0});
#endif
            if (s != 2 && bid < 44) {
                pg8::SplitKOrder SK{4, 11, 256, 44, bid};
                pg8::gemm_phase(lds, pg8::Gemm{p.act_s(), p.w_ffout2(), 256, DM, 256, DFF}, SK, pg8::EpiPartial{p.part()});
            }
        } break;
        case 3: norm_phase(p.xres(), nullptr, nullptr, p.norm_mix + l * DM, p.xb(), nullptr, 0, T_P, bid, nblk); break;
        case 4: {
            pg8::StaticOrder S; S.init(T_P, LDP, nblk, bid);
            pg8::gemm_phase(lds, pg8::Gemm{p.xb(), p.w_mixin(), T_P, LDP, DM, DM}, S, pg8::EpiBf16{p.pbuf(), LDP, 0});
        } break;
        case 5: {
            if (team) {
                sample_stage_a(p, l, lds, tr, tgt); team_barrier(p.bar() + XCD_BAR_WORDS, tgt); sample_stage_b(p, l, lds, tr, tgt);
                if (l + 1 < DEPTH) {
                    convert_w(p.ff1_w_in + (size_t)(l + 1) * DM * 2 * DFF, DM, 2 * DFF, p.w_ffin1(), 2 * DFF, 1, lds, tr, TEAM);
                    convert_w(p.ff1_w_out + (size_t)(l + 1) * DFF * DM, DFF, DM, p.w_ffout1(), DM, 0, lds, tr, TEAM);
                    convert_w(p.w_mix_in + (size_t)(l + 1) * DM * DIN, DM, DIN, p.w_mixin(), LDP, 0, lds, tr, TEAM);
                }
                break;
            }
            unsigned* flags_l = p.bar() + XCD_BAR_WORDS + 64 + l * 1024;
            const int nprep = nwk - 32;
            int a0, astep, aend;
            if ((bid < 64) && ((bid & 7) < 4)) {
                const int h = bid & 7, slice = bid >> 3;
                scan_run(p, lds, h, 4, nullptr, p.out + O_DELTAP + (size_t)(l * 4 + h) * 16384, slice, flags_l + h);
                a0 = 0; astep = 1; aend = 0;
            } else {
                const int rank = bid < 64 ? (bid >> 3) * 4 + (bid & 7) - 4 : bid - 32;
                for (int w = rank; w < NCH * 4; w += nprep) {
                    const int c = w >> 2, h = w & 3;
                    gdn_prep<64>(p, l, w, h, c * 64, nullptr, true, c == NCH - 1 ? p.out + O_CONVP + (size_t)l * 3 * 1536 : nullptr, lds, flags_l + w);
                }
                if (nprep == 192) { if (rank < 64) { a0 = rank; astep = 64; aend = 128; } else { a0 = 128 + (rank - 64); astep = 128; aend = NCH * 2; } }
                else { a0 = rank; astep = nprep; aend = NCH * 2; }
            }
            for (int a = a0; a < aend; a += astep) {
                const int c = a >> 1, kvh = a & 1;
                const bool last = (c == NCH - 1);
                swa_item<64, 192>(p, l, kvh, c * 64, c * 64, (c - 2) * 64, (c - 2) * 64, 0, nullptr, nullptr,
                                  last ? p.out + O_KP + (size_t)l * 128 * 128 : nullptr, last ? p.out + O_VP + (size_t)l * 128 * 128 : nullptr, 64, lds);
            }
        } break;
        case 6: {
            for (int w = bid; w < NCH * 4; w += nblk) gdn_out<64>(p, l, w, w & 3, (w >> 2) * 64, lds);
        } break;
        case 7: {
            pg8::StaticOrder S; S.init(T_P, DM, nblk, bid);
            pg8::gemm_phase(lds, pg8::Gemm{p.xb(), p.w_mixout(), T_P, DM, DM, DM}, S, pg8::EpiResid{p.xres(), 1.0f, 0});
        } break;
        case 8: norm_phase(p.xres(), nullptr, nullptr, p.norm_ff2 + l * DM, p.xb(), nullptr, 0, T_P, bid, nblk); break;
        }
#ifdef DUP_PHASE
        }
#endif
    }
}

extern "C" void kernel_launch(void* const* d_in, const int* in_sizes, int n_in, void* d_out, int out_size, void* d_ws, size_t ws_size, hipStream_t stream) {
    static int grid_blocks = 0;
    if (!grid_blocks) {
        hipFuncSetAttribute((const void*)fwd_megakernel, hipFuncAttributeMaxDynamicSharedMemorySize, LDS_BYTES);
        int dev = 0, cus = 0, per_cu = 0;
        hipGetDevice(&dev);
        hipDeviceGetAttribute(&cus, hipDeviceAttributeMultiprocessorCount, dev);
        hipOccupancyMaxActiveBlocksPerMultiprocessor(&per_cu, fwd_megakernel, NTHR, LDS_BYTES);
        if (per_cu < 1) per_cu = 1;
        grid_blocks = cus;
        if (grid_blocks > 256) grid_blocks = 256;
    }
    Params p{};
    const float* const* in = (const float* const*)d_in;
    p.x_prompt = in[0]; p.x_sample = in[1]; p.cache_conv = in[2]; p.state_delta = in[3]; p.cache_k = in[4]; p.cache_v = in[5];
    p.norm_ff1 = in[6]; p.ff1_w_in = in[7]; p.ff1_w_out = in[8]; p.norm_mix = in[9]; p.w_mix_in = in[10]; p.conv_w = in[11]; p.a_log = in[12]; p.dt_bias = in[13];
    p.gnorm_w = in[14]; p.sinks = in[15]; p.w_mix_out = in[16]; p.norm_ff2 = in[17]; p.ff2_w_in = in[18]; p.ff2_w_out = in[19]; p.norm_final = in[20];
    p.out = (float*)d_out;
    p.ws = (char*)d_ws;
    if (WS_NEED > ws_size) fprintf(stderr, "workspace too small: need %zu have %zu\n", (size_t)WS_NEED, ws_size);
    p.phase_lo = 0; p.phase_hi = N_PHASE - 1;
    (void)hipMemsetAsync(p.bar(), 0, (size_t)(XCD_BAR_WORDS + 64 + 4096) * 4, stream);
    void* args[] = {&p};
    hipError_t e = hipLaunchCooperativeKernel((const void*)fwd_megakernel, dim3(grid_blocks), dim3(NTHR), args, LDS_BYTES, stream);
    if (e != hipSuccess) fprintf(stderr, "cooperative launch failed: %s (grid %d)\n", hipGetErrorString(e), grid_blocks);
}
```

```cpp
#include <hip/hip_runtime.h>
#include <hip/hip_cooperative_groups.h>
#include <cstdio>
#include <type_traits>
namespace cg = cooperative_groups;

#define LAS __attribute__((address_space(3)))
#define DI __device__ __forceinline__
typedef unsigned short bf16_t;
typedef short bf16x8 __attribute__((ext_vector_type(8)));
typedef float f32x4 __attribute__((ext_vector_type(4)));
typedef unsigned u32x2 __attribute__((ext_vector_type(2)));
typedef unsigned u32x4 __attribute__((ext_vector_type(4)));

constexpr int T_ALL = 16640, T_P = 16384, N_S = 8, L_S = 32;
constexpr int DM = 1024, DFF = 2816, DIN = 2824, LDP = 3072, DEPTH = 4;
constexpr int NCH = 256;
constexpr int N_ITEM = NCH * 4 + N_S * 4;
constexpr int LDS_BYTES = 152 * 1024;
constexpr int NTHR = 512;
constexpr float EPS = 1e-6f;


constexpr size_t al256(size_t x) { return (x + 255) & ~(size_t)255; }
constexpr size_t OFF_XRES = 0;
constexpr size_t OFF_XB = OFF_XRES + al256((size_t)T_ALL * DM * 4);
constexpr size_t OFF_WFFIN1 = OFF_XB + al256((size_t)T_ALL * DM * 2);
constexpr size_t OFF_WFFOUT1 = OFF_WFFIN1 + al256((size_t)2 * DFF * DM * 2);
constexpr size_t OFF_WMIXIN = OFF_WFFOUT1 + al256((size_t)DM * DFF * 2);
constexpr size_t OFF_WMIXOUT = OFF_WMIXIN + al256((size_t)LDP * DM * 2);
constexpr size_t OFF_WFFIN2 = OFF_WMIXOUT + al256((size_t)DM * DM * 2);
constexpr size_t OFF_WFFOUT2 = OFF_WFFIN2 + al256((size_t)2 * DFF * DM * 2);
constexpr size_t OFF_BAR = OFF_WFFOUT2 + al256((size_t)DM * DFF * 2);
constexpr size_t OFF_ACTS = OFF_BAR + al256((size_t)(3456 + 64 + 4096) * 4);
constexpr size_t OFF_GTOT = OFF_ACTS + al256((size_t)256 * DFF * 2);
constexpr size_t OFF_UNION = OFF_GTOT + al256((size_t)N_ITEM * 4);
constexpr size_t OFF_ACT = OFF_UNION;
constexpr size_t OFF_PBUF = OFF_UNION;
constexpr size_t OFF_ANEG = OFF_PBUF + al256((size_t)T_ALL * LDP * 2);
constexpr size_t OFF_BT = OFF_ANEG + al256((size_t)N_ITEM * 16384 * 2);
constexpr size_t OFF_ST = OFF_BT + al256((size_t)N_ITEM * 16384 * 2);
constexpr size_t OFF_QP = OFF_ST + al256((size_t)(N_ITEM + 1) * 16384 * 2);
constexpr size_t OFF_OP = OFF_QP + al256((size_t)N_ITEM * 8192 * 2);
constexpr size_t OFF_PART = OFF_OP + al256((size_t)N_ITEM * 8192 * 2);
constexpr size_t WS_NEED = OFF_PART + al256((size_t)11 * 256 * DM * 4);
static_assert(OFF_ACT + (size_t)T_ALL * DFF * 2 <= WS_NEED, "act fits the union");

struct Params {
    const float *x_prompt, *x_sample, *cache_conv, *state_delta, *cache_k, *cache_v;
    const float *norm_ff1, *ff1_w_in, *ff1_w_out, *norm_mix, *w_mix_in, *conv_w, *a_log, *dt_bias;
    const float *gnorm_w, *sinks, *w_mix_out, *norm_ff2, *ff2_w_in, *ff2_w_out, *norm_final;
    float* out;
    char* ws;
    __host__ __device__ __forceinline__ float* part() const { return (float*)(ws + OFF_PART); }
    __host__ __device__ __forceinline__ float* xres() const { return (float*)(ws + OFF_XRES); }
    __host__ __device__ __forceinline__ bf16_t* xb() const { return (bf16_t*)(ws + OFF_XB); }
    __host__ __device__ __forceinline__ bf16_t* act() const { return (bf16_t*)(ws + OFF_ACT); }
    __host__ __device__ __forceinline__ bf16_t* pbuf() const { return (bf16_t*)(ws + OFF_PBUF); }
    __host__ __device__ __forceinline__ bf16_t* Aneg() const { return (bf16_t*)(ws + OFF_ANEG); }
    __host__ __device__ __forceinline__ bf16_t* BT() const { return (bf16_t*)(ws + OFF_BT); }
    __host__ __device__ __forceinline__ bf16_t* Qp() const { return (bf16_t*)(ws + OFF_QP); }
    __host__ __device__ __forceinline__ bf16_t* Op() const { return (bf16_t*)(ws + OFF_OP); }
    __host__ __device__ __forceinline__ bf16_t* ST() const { return (bf16_t*)(ws + OFF_ST); }
    __host__ __device__ __forceinline__ float* gtot() const { return (float*)(ws + OFF_GTOT); }
    __host__ __device__ __forceinline__ unsigned* bar() const { return (unsigned*)(ws + OFF_BAR); }
    __host__ __device__ __forceinline__ bf16_t* act_s() const { return (bf16_t*)(ws + OFF_ACTS); }
    __host__ __device__ __forceinline__ bf16_t* w_ffin1() const { return (bf16_t*)(ws + OFF_WFFIN1); }
    __host__ __device__ __forceinline__ bf16_t* w_ffout1() const { return (bf16_t*)(ws + OFF_WFFOUT1); }
    __host__ __device__ __forceinline__ bf16_t* w_mixin() const { return (bf16_t*)(ws + OFF_WMIXIN); }
    __host__ __device__ __forceinline__ bf16_t* w_mixout() const { return (bf16_t*)(ws + OFF_WMIXOUT); }
    __host__ __device__ __forceinline__ bf16_t* w_ffin2() const { return (bf16_t*)(ws + OFF_WFFIN2); }
    __host__ __device__ __forceinline__ bf16_t* w_ffout2() const { return (bf16_t*)(ws + OFF_WFFOUT2); }
    int phase_lo, phase_hi;
};

constexpr size_t O_Y = 0;
constexpr size_t O_CONVP = (size_t)T_ALL * DM;
constexpr size_t O_DELTAP = O_CONVP + 4 * 3 * 1536;
constexpr size_t O_KP = O_DELTAP + 4 * 4 * 128 * 128;
constexpr size_t O_VP = O_KP + 4 * 128 * 128;
constexpr size_t O_CONVS = O_VP + 4 * 128 * 128;
constexpr size_t O_DELTAS = O_CONVS + 4 * 8 * 3 * 1536;
constexpr size_t O_KS = O_DELTAS + (size_t)4 * 8 * 4 * 128 * 128;
constexpr size_t O_VS = O_KS + 4 * 8 * 128 * 128;

DI float bf2f(bf16_t v) { return __uint_as_float(((unsigned)v) << 16); }
typedef float f32x2v __attribute__((ext_vector_type(2)));
typedef __bf16 bf16x2v __attribute__((ext_vector_type(2)));
DI unsigned pack2(float a, float b) { const f32x2v v = {a, b}; const bf16x2v r = __builtin_convertvector(v, bf16x2v); return __builtin_bit_cast(unsigned, r); }
DI bf16_t f2bf(float f) { return (bf16_t)(pack2(f, 0.f) & 0xffffu); }
DI float lo2f(unsigned u) { return __uint_as_float(u << 16); }
DI float hi2f(unsigned u) { return __uint_as_float(u & 0xffff0000u); }
template <int CTRL> DI float dpp_mov(float v) { return __int_as_float(__builtin_amdgcn_update_dpp(0, __float_as_int(v), CTRL, 0xf, 0xf, false)); }
DI float rl(float v, int l) { return __int_as_float(__builtin_amdgcn_readlane(__float_as_int(v), l)); }
DI float wave_sum(float v) {
    v += dpp_mov<0xB1>(v); v += dpp_mov<0x4E>(v); v += dpp_mov<0x141>(v); v += dpp_mov<0x140>(v);
    return (rl(v, 0) + rl(v, 16)) + (rl(v, 32) + rl(v, 48));
}
DI float wave_max(float v) {
    v = fmaxf(v, dpp_mov<0xB1>(v)); v = fmaxf(v, dpp_mov<0x4E>(v)); v = fmaxf(v, dpp_mov<0x141>(v)); v = fmaxf(v, dpp_mov<0x140>(v));
    return fmaxf(fmaxf(rl(v, 0), rl(v, 16)), fmaxf(rl(v, 32), rl(v, 48)));
}
DI void lds_barrier() { asm volatile("s_waitcnt lgkmcnt(0)\n\ts_barrier" ::: "memory"); }
DI int tid_opaque() { int t = threadIdx.x; asm volatile("" : "+v"(t)); return t; }
DI float silu_f(float x) { return x * __builtin_amdgcn_rcpf(1.f + __expf(-x)); }
DI void load16bf(const bf16_t* s, float (&x)[16]) {
    const u32x4 a = *(const u32x4*)s, b = *(const u32x4*)(s + 8);
#pragma unroll
    for (int e = 0; e < 4; ++e) { x[2 * e] = lo2f(a[e]); x[2 * e + 1] = hi2f(a[e]); x[8 + 2 * e] = lo2f(b[e]); x[8 + 2 * e + 1] = hi2f(b[e]); }
}


#define XB_TMO      128
#define XB_XCNT(j)  (256  + 64 * (j))
#define XB_XSUB(j)  (1280 + 64 * (j))
#define XB_XGEN(j)  (2304 + 64 * (j))
#define XB_TOP      3328
#define XB_TOPGEN   3392
#define XCD_BAR_WORDS 3456
#define XB_SPIN_CAP (1u << 20)
DI unsigned xb_ld(unsigned* p)              { return __hip_atomic_load(p, __ATOMIC_RELAXED, __HIP_MEMORY_SCOPE_AGENT); }
DI unsigned xb_add(unsigned* p, unsigned v) { return __hip_atomic_fetch_add(p, v, __ATOMIC_RELAXED, __HIP_MEMORY_SCOPE_AGENT); }
DI unsigned xb_xcc_id() { return (unsigned)__builtin_amdgcn_s_getreg((3 << 11) | 20) & 0xFu; }
#define XB_SPIN(cond, bar) do { unsigned _sp = 0; while (cond) { __builtin_amdgcn_s_sleep(1); \
    if ((++_sp & 255u) == 0u) { if (xb_ld(&(bar)[XB_TMO])) break; if (_sp > XB_SPIN_CAP) { atomicAdd(&(bar)[XB_TMO], 1u); break; } } } } while (0)
struct XcdBarrier { unsigned* bar; unsigned x; volatile LAS unsigned* st; };
DI XcdBarrier xcd_barrier_post(unsigned* bar, volatile LAS unsigned* st) {
    XcdBarrier b; b.bar = bar; b.x = xb_xcc_id(); b.st = st;
    if (threadIdx.x == 0) (void)xb_add(&bar[XB_XCNT(b.x)], 1u);
    return b;
}
DI void xcd_barrier_complete(unsigned* bar, unsigned x, unsigned& nloc, unsigned& nx) {
    const unsigned G = gridDim.x * gridDim.y * gridDim.z;
    unsigned sum, cnt, mine, sp = 0u;
    for (;;) {
        sum = 0u; cnt = 0u; mine = 0u;
#pragma unroll
        for (unsigned j = 0; j < 16; ++j) { const unsigned c = xb_ld(&bar[XB_XCNT(j)]); sum += c; cnt += (c > 0u) ? 1u : 0u; mine = (j == x) ? c : mine; }
        if (sum == G) break;
        __builtin_amdgcn_s_sleep(1);
        if ((++sp & 255u) == 0u) { if (xb_ld(&bar[XB_TMO])) break; if (sp > XB_SPIN_CAP) { atomicAdd(&bar[XB_TMO], 1u); break; } }
    }
    nloc = mine > 0u ? mine : 1u; nx = cnt > 0u ? cnt : 1u;
}
DI void xcd_barrier(const XcdBarrier& b) {
    asm volatile("s_waitcnt vmcnt(0)" ::: "memory");
    __syncthreads();
    if (threadIdx.x == 0) {
        unsigned* bar = b.bar;
        __builtin_amdgcn_s_waitcnt(0);
        unsigned nloc = b.st[0], nx = b.st[1];
        if (nloc == 0u) { xcd_barrier_complete(bar, b.x, nloc, nx); b.st[0] = nloc; b.st[1] = nx; }
        const unsigned old = xb_add(&bar[XB_XSUB(b.x)], 1u);
        const unsigned gen = old / nloc;
        if (old + 1u == (gen + 1u) * nloc) {
            __builtin_amdgcn_fence(__ATOMIC_RELEASE, "agent");
            asm volatile("s_waitcnt vmcnt(0)" ::: "memory");
            const unsigned og = xb_add(&bar[XB_TOP], 1u);
            const unsigned tg = og / nx;
            if (og + 1u == (tg + 1u) * nx) xb_add(&bar[XB_TOPGEN], 1u);
            else XB_SPIN(xb_ld(&bar[XB_TOPGEN]) == tg, bar);
            __builtin_amdgcn_fence(__ATOMIC_ACQUIRE, "agent");
            xb_add(&bar[XB_XGEN(b.x)], 1u);
            asm volatile("s_waitcnt vmcnt(0)" ::: "memory");
        } else {
            XB_SPIN(xb_ld(&bar[XB_XGEN(b.x)]) == gen, bar);
            __builtin_amdgcn_fence(__ATOMIC_ACQUIRE, "agent");
            asm volatile("s_waitcnt vmcnt(0)" ::: "memory");
        }
    }
    __syncthreads();
}

constexpr int TEAM = 32;
DI void team_barrier(unsigned* cnt, unsigned& target) {
    asm volatile("s_waitcnt vmcnt(0)" ::: "memory");
    __syncthreads();
    if (threadIdx.x == 0) {
        target += TEAM;
        __builtin_amdgcn_fence(__ATOMIC_RELEASE, "agent");
        asm volatile("s_waitcnt vmcnt(0)" ::: "memory");
        xb_add(cnt, 1u);
        unsigned sp = 0;
        while (xb_ld(cnt) < target) { __builtin_amdgcn_s_sleep(1); if (++sp > (1u << 22)) break; }
        __builtin_amdgcn_fence(__ATOMIC_ACQUIRE, "agent");
        asm volatile("s_waitcnt vmcnt(0)" ::: "memory");
    }
    __syncthreads();
}

namespace pg8 {
constexpr int BM = 256, BK = 64, HALF = 128, HTB = HALF * BK * 2, STAGE_BYTES = 8 * HTB, NXCD = 8, WGM = 8;
DI int lds_byte(int r, int c) { const int st = (r >> 4) * 2 + (c >> 5), rr = r & 15, cc = c & 31, ob = rr * 64 + cc * 2; return st * 1024 + (ob ^ (((ob >> 9) & 1) << 5)); }
DI void stage_rc(int b, int& R, int& C) { const int st = b / 1024, sb = b % 1024, swz = sb ^ (((sb >> 9) & 1) << 5); R = (st >> 1) * 16 + swz / 64; C = (st & 1) * 32 + (swz % 64) / 2; }
DI int perm32(int rho) { const int n = rho >> 4, i = rho & 15; return 8 * (i >> 2) + 4 * n + (i & 3); }
struct Unit { int pm, pn, koff; };
struct Gemm { const bf16_t* A; const bf16_t* Bt; int M, N, K, ld; };
struct StaticOrder {
    int nM, nN, nwg, G, c;
    DI void init(int M, int N, int G_, int c_) { nM = M / BM; nN = N / BM; nwg = nM * nN; G = G_; c = c_; }
    DI bool next(int i, Unit& u) const {
        const long L = (long)i * G + c; if (L >= nwg) return false;
        int wgid = (int)L; { const int q = nwg / NXCD, r = nwg % NXCD, xcd = wgid % NXCD, off = wgid / NXCD; wgid = (xcd < r ? xcd * (q + 1) : r * (q + 1) + (xcd - r) * q) + off; }
        const int nig = WGM * nN, gid = wgid / nig, fm = gid * WGM, gsz = (nM - fm) < WGM ? (nM - fm) : WGM;
        u.pm = fm + ((wgid % nig) % gsz); u.pn = (wgid % nig) / gsz; u.koff = 0; return true;
    }
};

template <class Epi, class Sched>
DI void gemm_phase(LAS unsigned char* lds, const Gemm g, const Sched& S, const Epi& E) {
    const int tid = tid_opaque(), wid = __builtin_amdgcn_readfirstlane(tid >> 6), lane = tid & 63, wr = wid >> 2, wc = wid & 3, fr = lane & 15, fq = lane >> 4;
    const int K = g.ld, nt = g.K / BK;
    unsigned voffA[2], voffB[2];
#pragma unroll
    for (int i = 0; i < 2; ++i) { int R, C; stage_rc(tid * 16 + i * 8192, R, C); const int Rb = Epi::PERM ? ((R & ~31) + perm32(R & 31)) : R;
        voffA[i] = (unsigned)(R * K + C) * 2u; voffB[i] = (unsigned)(Rb * K + C) * 2u; }
    const size_t kstep = (size_t)(BK * 2);
    const size_t hstep = (size_t)HALF * K * 2;
    const size_t tstep = 2 * hstep;
    const unsigned ldsw = (unsigned)wid * 1024u;
    const int aoff = lds_byte(wr * 64 + fr, fq * 8), boff = lds_byte(wc * 32 + fr, fq * 8);
#define PG8_SA(b, h) (((b) * 2 + (h)) * HTB)
#define PG8_SB(b, h) ((4 + (b) * 2 + (h)) * HTB)
#define PG8_STAGE(bufoff, gbase, voff) do { _Pragma("unroll") for (int _i = 0; _i < 2; ++_i) \
        __builtin_amdgcn_global_load_lds((const unsigned*)((const char*)(gbase) + (voff)[_i]), (LAS unsigned*)(lds + (bufoff) + ldsw + _i * 8192), 16, 0, 0); } while (0)
#define PG8_LDA(dst, b, h) do { _Pragma("unroll") for (int m = 0; m < 4; ++m) _Pragma("unroll") for (int k = 0; k < 2; ++k) dst[m][k] = *(const LAS bf16x8*)(lds + PG8_SA(b, h) + aoff + m * 2048 + k * 1024); } while (0)
#define PG8_LDB(dst, b, h) do { _Pragma("unroll") for (int n = 0; n < 2; ++n) _Pragma("unroll") for (int k = 0; k < 2; ++k) dst[n][k] = *(const LAS bf16x8*)(lds + PG8_SB(b, h) + boff + n * 2048 + k * 1024); } while (0)
#define PG8_MMA(ai, bj, At, Bt) do { __builtin_amdgcn_s_setprio(1); _Pragma("unroll") for (int m = 0; m < 4; ++m) _Pragma("unroll") for (int n = 0; n < 2; ++n) _Pragma("unroll") for (int k = 0; k < 2; ++k) \
        acc[ai][bj][m][n] = __builtin_amdgcn_mfma_f32_16x16x32_bf16(Bt[n][k], At[m][k], acc[ai][bj][m][n], 0, 0, 0); __builtin_amdgcn_s_setprio(0); } while (0)
#define PG8_WAIT_V(n) asm volatile("s_waitcnt vmcnt(" #n ")" ::: "memory")
#define PG8_WAIT_L(n) asm volatile("s_waitcnt lgkmcnt(" #n ")" ::: "memory")
#define PG8_BAR __builtin_amdgcn_s_barrier()
#define PG8_SCHED __builtin_amdgcn_sched_barrier(0)
    Unit cur, nxt; int ui = 0;
    if (!S.next(0, cur)) return;
    f32x4 acc[2][2][4][2];
#pragma unroll
    for (int a = 0; a < 2; ++a)
#pragma unroll
        for (int b = 0; b < 2; ++b)
#pragma unroll
            for (int m = 0; m < 4; ++m)
#pragma unroll
                for (int n = 0; n < 2; ++n) acc[a][b][m][n] = (f32x4){0.f, 0.f, 0.f, 0.f};
    bf16x8 At[4][2], B0[2][2], B1[2][2];
    const char* cA = (const char*)g.A + (size_t)cur.pm * tstep + cur.koff; const char* cB = (const char*)g.Bt + (size_t)cur.pn * tstep + cur.koff;
    PG8_STAGE(PG8_SB(0, 0), cB, voffB); PG8_STAGE(PG8_SA(0, 0), cA, voffA); PG8_STAGE(PG8_SB(0, 1), cB + hstep, voffB); PG8_STAGE(PG8_SA(0, 1), cA + hstep, voffA);
    if (wr == 1) PG8_BAR;
    PG8_WAIT_V(4); PG8_BAR;
    PG8_STAGE(PG8_SB(1, 0), cB + kstep, voffB); PG8_STAGE(PG8_SA(1, 0), cA + kstep, voffA); PG8_STAGE(PG8_SB(1, 1), cB + hstep + kstep, voffB);
    PG8_WAIT_V(6); PG8_BAR;
    for (;;) {
        const bool has_next = S.next(ui + 1, nxt);
        const char* nA = has_next ? (const char*)g.A + (size_t)nxt.pm * tstep + nxt.koff : cA; const char* nB = has_next ? (const char*)g.Bt + (size_t)nxt.pn * tstep + nxt.koff : cB;
        for (int t = 0; t < nt; t += 2) {
            const bool last = (t == nt - 2);
            const char* a1 = cA + (size_t)(t + 1) * kstep;
            const char* a2 = last ? nA : cA + (size_t)(t + 2) * kstep; const char* b2 = last ? nB : cB + (size_t)(t + 2) * kstep;
            const char* a3 = a2 + kstep; const char* b3 = b2 + kstep;
            PG8_LDB(B0, 0, 0); PG8_SCHED; PG8_LDA(At, 0, 0); PG8_STAGE(PG8_SA(1, 1), a1 + hstep, voffA);
            PG8_WAIT_L(8); PG8_BAR; PG8_WAIT_L(0); PG8_MMA(0, 0, At, B0); PG8_BAR; PG8_SCHED;
            PG8_LDB(B1, 0, 1); PG8_STAGE(PG8_SB(0, 0), b2, voffB);
            PG8_BAR; PG8_WAIT_L(0); PG8_MMA(0, 1, At, B1); PG8_BAR;
            PG8_LDA(At, 0, 1); PG8_STAGE(PG8_SA(0, 0), a2, voffA);
            PG8_BAR; PG8_WAIT_L(0); PG8_MMA(1, 0, At, B0); PG8_BAR; PG8_SCHED;
            PG8_STAGE(PG8_SB(0, 1), b2 + hstep, voffB);
            PG8_WAIT_V(6); PG8_BAR; PG8_MMA(1, 1, At, B1); PG8_BAR;
            PG8_LDB(B0, 1, 0); PG8_SCHED; PG8_LDA(At, 1, 0); PG8_STAGE(PG8_SA(0, 1), a2 + hstep, voffA);
            PG8_WAIT_L(8); PG8_BAR; PG8_WAIT_L(0); PG8_MMA(0, 0, At, B0); PG8_BAR; PG8_SCHED;
            PG8_LDB(B1, 1, 1); PG8_STAGE(PG8_SB(1, 0), b3, voffB);
            PG8_BAR; PG8_WAIT_L(0); PG8_MMA(0, 1, At, B1); PG8_BAR;
            PG8_LDA(At, 1, 1); PG8_STAGE(PG8_SA(1, 0), a3, voffA);
            PG8_BAR; PG8_WAIT_L(0); PG8_MMA(1, 0, At, B0); PG8_BAR; PG8_SCHED;
            PG8_STAGE(PG8_SB(1, 1), b3 + hstep, voffB);
            PG8_WAIT_V(6); PG8_BAR; PG8_MMA(1, 1, At, B1); PG8_BAR;
        }
        E(acc, cur, wr, wc, fr, fq);
        if (!has_next) break;
#pragma unroll
        for (int a = 0; a < 2; ++a)
#pragma unroll
            for (int b = 0; b < 2; ++b)
#pragma unroll
                for (int m = 0; m < 4; ++m)
#pragma unroll
                    for (int n = 0; n < 2; ++n) acc[a][b][m][n] = (f32x4){0.f, 0.f, 0.f, 0.f};
        cur = nxt; cA = nA; cB = nB; ++ui;
    }
    PG8_WAIT_V(0);
    if (wr == 0) PG8_BAR;
    PG8_BAR;
#undef PG8_SA
#undef PG8_SB
#undef PG8_STAGE
#undef PG8_LDA
#undef PG8_LDB
#undef PG8_MMA
#undef PG8_WAIT_V
#undef PG8_WAIT_L
#undef PG8_BAR
#undef PG8_SCHED
}
struct SplitKOrder {
    int nN, nS, ksub, G, c;
    DI bool next(int i, Unit& u) const {
        const int L = i * G + c; if (L >= nN * nS) return false;
        u.pm = 0; u.pn = L % nN; u.koff = (L / nN) * ksub * 2; return true;
    }
};
struct EpiSwiglu {
    static constexpr bool PERM = true;
    bf16_t* O; int row0; bf16_t* O2;
    DI void operator()(const f32x4 (&acc)[2][2][4][2], const Unit& u, int wr, int wc, int fr, int fq) const {
        bf16_t* Ob = (row0 + u.pm * 256 >= T_P) ? O2 - (size_t)T_P * DFF : O;
#pragma unroll
        for (int ai = 0; ai < 2; ++ai)
#pragma unroll
            for (int m = 0; m < 4; ++m) {
                const size_t r = (size_t)row0 + u.pm * 256 + ai * 128 + wr * 64 + m * 16 + fr;
                u32x4 o;
#pragma unroll
                for (int n = 0; n < 2; ++n) {
                    const f32x4 g = acc[ai][0][m][n], up = acc[ai][1][m][n];
                    o[2 * n] = pack2(silu_f(g[0]) * up[0], silu_f(g[1]) * up[1]); o[2 * n + 1] = pack2(silu_f(g[2]) * up[2], silu_f(g[3]) * up[3]);
                }
                *(u32x4*)(Ob + r * DFF + u.pn * 128 + wc * 32 + fq * 8) = o;
            }
    }
};
struct EpiResid {
    static constexpr bool PERM = false;
    float* X; float scale; int row0;
    DI void operator()(const f32x4 (&acc)[2][2][4][2], const Unit& u, int wr, int wc, int fr, int fq) const {
#pragma unroll
        for (int ai = 0; ai < 2; ++ai)
#pragma unroll
            for (int m = 0; m < 4; ++m) {
                const size_t r = (size_t)row0 + u.pm * 256 + ai * 128 + wr * 64 + m * 16 + fr;
#pragma unroll
                for (int bj = 0; bj < 2; ++bj)
#pragma unroll
                    for (int n = 0; n < 2; ++n) {
                        float* ptr = X + r * DM + u.pn * 256 + bj * 128 + wc * 32 + n * 16 + fq * 4;
                        f32x4 v = *(f32x4*)ptr; v += acc[ai][bj][m][n] * scale; *(f32x4*)ptr = v;
                    }
            }
    }
};
struct EpiPartial {
    static constexpr bool PERM = false;
    float* P;
    DI void operator()(const f32x4 (&acc)[2][2][4][2], const Unit& u, int wr, int wc, int fr, int fq) const {
        const size_t ks = (size_t)(u.koff >> 9);
#pragma unroll
        for (int ai = 0; ai < 2; ++ai)
#pragma unroll
            for (int m = 0; m < 4; ++m) {
                const size_t r = ks * 256 + ai * 128 + wr * 64 + m * 16 + fr;
#pragma unroll
                for (int bj = 0; bj < 2; ++bj)
#pragma unroll
                    for (int n = 0; n < 2; ++n) *(f32x4*)(P + r * DM + u.pn * 256 + bj * 128 + wc * 32 + n * 16 + fq * 4) = acc[ai][bj][m][n];
            }
    }
};
struct EpiResidAtomic {
    static constexpr bool PERM = false;
    float* X; float scale; int row0;
    DI void operator()(const f32x4 (&acc)[2][2][4][2], const Unit& u, int wr, int wc, int fr, int fq) const {
#pragma unroll
        for (int ai = 0; ai < 2; ++ai)
#pragma unroll
            for (int m = 0; m < 4; ++m) {
                const size_t r = (size_t)row0 + u.pm * 256 + ai * 128 + wr * 64 + m * 16 + fr;
#pragma unroll
                for (int bj = 0; bj < 2; ++bj)
#pragma unroll
                    for (int n = 0; n < 2; ++n) {
                        float* ptr = X + r * DM + u.pn * 256 + bj * 128 + wc * 32 + n * 16 + fq * 4;
#pragma unroll
                        for (int e = 0; e < 4; ++e) unsafeAtomicAdd(ptr + e, acc[ai][bj][m][n][e] * scale);
                    }
            }
    }
};
struct EpiBf16 {
    static constexpr bool PERM = true;
    bf16_t* O; int ldc; int row0;
    DI void operator()(const f32x4 (&acc)[2][2][4][2], const Unit& u, int wr, int wc, int fr, int fq) const {
#pragma unroll
        for (int ai = 0; ai < 2; ++ai)
#pragma unroll
            for (int m = 0; m < 4; ++m) {
                const size_t r = (size_t)row0 + u.pm * 256 + ai * 128 + wr * 64 + m * 16 + fr;
#pragma unroll
                for (int bj = 0; bj < 2; ++bj) {
                    const f32x4 a0 = acc[ai][bj][m][0], a1 = acc[ai][bj][m][1];
                    u32x4 o; o[0] = pack2(a0[0], a0[1]); o[1] = pack2(a0[2], a0[3]); o[2] = pack2(a1[0], a1[1]); o[3] = pack2(a1[2], a1[3]);
                    *(u32x4*)(O + r * ldc + u.pn * 256 + bj * 128 + wc * 32 + fq * 8) = o;
                }
            }
    }
};
}

template <int M, int N, int K, class F>
DI void lds_mm(LAS unsigned char* lds, int aoff, int lda, int boff, int ldb, F f) {
    const int tid = tid_opaque(), wave = tid >> 6, lane = tid & 63, fr = lane & 15, fq = lane >> 4;
    constexpr int TN = N / 16, NT = (M / 16) * TN;
    constexpr int TB = (NT % 32 == 0) ? 4 : ((NT % 16 == 0) ? 2 : 1);
    for (int tile0 = wave * TB; tile0 < NT; tile0 += 8 * TB) {
        f32x4 acc[TB];
        int ao[TB], bo[TB];
#pragma unroll
        for (int u = 0; u < TB; ++u) {
            const int tile = tile0 + u, tm = tile / TN, tn = tile % TN;
            acc[u] = (f32x4){0.f, 0.f, 0.f, 0.f};
            ao[u] = aoff + (tm * 16 + fr) * lda + fq * 16; bo[u] = boff + (tn * 16 + fr) * ldb + fq * 16;
        }
#pragma unroll
        for (int k0 = 0; k0 < K; k0 += 32) {
            bf16x8 a[TB], b[TB];
#pragma unroll
            for (int u = 0; u < TB; ++u) { a[u] = *(const LAS bf16x8*)(lds + ao[u] + k0 * 2); b[u] = *(const LAS bf16x8*)(lds + bo[u] + k0 * 2); }
#pragma unroll
            for (int u = 0; u < TB; ++u) acc[u] = __builtin_amdgcn_mfma_f32_16x16x32_bf16(a[u], b[u], acc[u], 0, 0, 0);
        }
#pragma unroll
        for (int u = 0; u < TB; ++u) { const int tile = tile0 + u; f((tile / TN) * 16 + fq * 4, (tile % TN) * 16 + fr, acc[u]); }
    }
}

DI void convert_w(const float* W, int K, int N, bf16_t* Bt, int Np, int mode, LAS unsigned char* lds, int bid, int nblk) {
    const int tid = tid_opaque();
    const int tn = Np / 64, tk = K / 64;
    LAS float* tl = (LAS float*)lds;
    for (int tile = bid; tile < tn * tk; tile += nblk) {
        const int n0 = (tile % tn) * 64, k0 = (tile / tn) * 64;
        {
            const int kk = tid >> 3, nn = (tid & 7) * 8, np = n0 + nn;
            int src; bool valid = true;
            if (mode == 1) { const int u = np >> 8, half = (np >> 7) & 1, i = np & 127; src = half * DFF + u * 128 + i; }
            else { src = np; valid = np < N; }
            f32x4 v0 = {0.f, 0.f, 0.f, 0.f}, v1 = {0.f, 0.f, 0.f, 0.f};
            if (valid) { const float* s = W + (size_t)(k0 + kk) * N + src; v0 = *(const f32x4*)s; v1 = *(const f32x4*)(s + 4); }
#pragma unroll
            for (int e = 0; e < 4; ++e) { tl[kk * 65 + nn + e] = v0[e]; tl[kk * 65 + nn + 4 + e] = v1[e]; }
        }
        __syncthreads();
        {
            const int nn = tid >> 3, kk = (tid & 7) * 8;
            u32x4 o;
#pragma unroll
            for (int e = 0; e < 4; ++e) o[e] = pack2(tl[(kk + 2 * e) * 65 + nn], tl[(kk + 2 * e + 1) * 65 + nn]);
            *(u32x4*)(Bt + (size_t)(n0 + nn) * K + k0 + kk) = o;
        }
        __syncthreads();
    }
}

DI void norm_phase(const float* src, const float* src2  , float* copy_to, const float* w, bf16_t* xb, float* yout,
                   int r_begin, int r_end, int wkr, int nwkr, const float* part = nullptr  ,
                   int nsplit = 11, float pscale = 0.5f) {
    const int tid = tid_opaque(); const int lane = tid & 63, gw = wkr * 8 + (tid >> 6), nw = nwkr * 8;
    f32x4 wv[4];
#pragma unroll
    for (int i = 0; i < 4; ++i) wv[i] = *(const f32x4*)(w + i * 256 + lane * 4);
    for (int r = r_begin + gw; r < r_end; r += nw) {
        const float* s = (src2 && r >= T_P) ? src2 + (size_t)(r - T_P) * DM : src + (size_t)r * DM;
        f32x4 v[4]; float ss = 0.f;
#pragma unroll
        for (int i = 0; i < 4; ++i) {
            v[i] = *(const f32x4*)(s + i * 256 + lane * 4);
            if (part && r >= T_P) {
                f32x4 a = {0.f, 0.f, 0.f, 0.f};
                for (int sp = 0; sp < nsplit; ++sp) a += *(const f32x4*)(part + ((size_t)sp * 256 + (r - T_P)) * DM + i * 256 + lane * 4);
                v[i] += a * pscale;
            }
            ss += v[i][0] * v[i][0] + v[i][1] * v[i][1] + v[i][2] * v[i][2] + v[i][3] * v[i][3];
        }
        ss = wave_sum(ss);
        const float rs = rsqrtf(ss * (1.f / DM) + EPS);
#pragma unroll
        for (int i = 0; i < 4; ++i) {
            if (copy_to && (!part || r >= T_P)) *(f32x4*)(copy_to + (size_t)r * DM + i * 256 + lane * 4) = v[i];
            f32x4 y = v[i] * rs * wv[i];
            if (xb) { u32x2 o; o[0] = pack2(y[0], y[1]); o[1] = pack2(y[2], y[3]); *(u32x2*)(xb + (size_t)r * DM + i * 256 + lane * 4) = o; }
            if (yout) *(f32x4*)(yout + (size_t)r * DM + i * 256 + lane * 4) = y;
        }
    }
}

DI int permcol(int b) { return (b & ~31) | (((b >> 2) & 3) << 3) | (((b >> 4) & 1) << 2) | (b & 3); }

template <int C>
DI void gdn_prep(const Params& p, int l, int item, int h, int row0, const float* cache, bool isprompt, float* conv_out, LAS unsigned char* lds, unsigned* flag = nullptr) {
    constexpr int LD = 272;
    constexpr int LC = (C + 8) * 2;
    constexpr int LL = 80;
    constexpr int CRLD = 260 * 4;
    constexpr int KN = 0, QN = KN + C * LD, VV = QN + C * LD, LM = VV + C * LD, LB = LM + C * LL, QK = LB + C * LC, KDT = QK + C * LC, WT = KDT + 128 * LC, UT = WT + 128 * LC,
                  CR = UT + 128 * LC, SC = CR + 16 * CRLD;
    static_assert(SC + 1024 <= LDS_BYTES - 16, "lds");
    const int tid = tid_opaque(), wave = tid >> 6, lane = tid & 63;
    LAS float* sc = (LAS float*)(lds + SC);
    const bf16_t* pb = p.pbuf();
    float cwa[3][4][2];
#pragma unroll
    for (int m = 0; m < 3; ++m)
#pragma unroll
        for (int j = 0; j < 4; ++j) {
            const float* cwp = p.conv_w + (size_t)(l * 4 + j) * 1536 + m * 512 + h * 128 + 2 * lane;
            cwa[m][j][0] = cwp[0]; cwa[m][j][1] = cwp[1];
        }
    bf16_t blr = 0, alr = 0; float dtb = 0.f, alg = 0.f;
    if (wave == 0) {
        if (lane < C) { blr = pb[(size_t)(row0 + lane) * LDP + 2048 + h]; alr = pb[(size_t)(row0 + lane) * LDP + 2052 + h]; }
        dtb = p.dt_bias[l * 4 + h]; alg = p.a_log[l * 4 + h];
    }
    constexpr int RAW = LM, RLD = 784;
    static_assert((C + 3) * RLD <= SC - LM, "raw tile");
    {
        constexpr int NCHK = (C + 3) * 48, NIT = (NCHK + NTHR - 1) / NTHR;
        u32x4 rv[NIT]; f32x4 c0[NIT], c1[NIT];
#pragma unroll
        for (int it = 0; it < NIT; ++it) {
            const int e = tid + it * NTHR, r = e / 48, ch = e % 48, m = ch >> 4, c8 = ch & 15, ti = r - 3;
            const int col = m * 512 + h * 128 + c8 * 8;
            rv[it] = (u32x4){0u, 0u, 0u, 0u}; c0[it] = (f32x4){0.f, 0.f, 0.f, 0.f}; c1[it] = c0[it];
            if (e < NCHK) {
                if (ti >= 0 || (isprompt && row0 + ti >= 0)) rv[it] = *(const u32x4*)(pb + (size_t)(row0 + ti) * LDP + col);
                else if (!isprompt) { c0[it] = *(const f32x4*)(cache + (3 + ti) * 1536 + col); c1[it] = *(const f32x4*)(cache + (3 + ti) * 1536 + col + 4); }
            }
        }
#pragma unroll
        for (int it = 0; it < NIT; ++it) {
            const int e = tid + it * NTHR, r = e / 48, ch = e % 48, ti = r - 3;
            if (e < NCHK) {
                u32x4 v = rv[it];
                if (!(ti >= 0 || (isprompt && row0 + ti >= 0)) && !isprompt) { v[0] = pack2(c0[it][0], c0[it][1]); v[1] = pack2(c0[it][2], c0[it][3]); v[2] = pack2(c1[it][0], c1[it][1]); v[3] = pack2(c1[it][2], c1[it][3]); }
                *(LAS u32x4*)(lds + RAW + r * RLD + ch * 16) = v;
            }
        }
    }
    __syncthreads();
#ifdef PROBE_CONV
    for (int prb = 0; prb < 2; ++prb)
#endif
#pragma unroll
    for (int m = 0; m < 3; ++m) {
        const int col = m * 512 + h * 128 + 2 * lane;
        float cw0[4], cw1[4];
#pragma unroll
        for (int j = 0; j < 4; ++j) { cw0[j] = cwa[m][j][0]; cw1[j] = cwa[m][j][1]; }
        const int dst = (m == 0 ? QN : (m == 1 ? KN : VV));
#pragma unroll
        for (int ii = 0; ii < C / 8; ++ii) {
            const int i = wave + ii * 8;
            float a0 = 0.f, a1 = 0.f, x0 = 0.f, x1 = 0.f;
#pragma unroll
            for (int j = 0; j < 4; ++j) {
                const unsigned u = *(const LAS unsigned*)(lds + RAW + (i + j) * RLD + m * 256 + lane * 4);
                x0 = lo2f(u); x1 = hi2f(u);
                a0 += cw0[j] * x0; a1 += cw1[j] * x1;
            }
            if (conv_out && i >= C - 3) { conv_out[(i - (C - 3)) * 1536 + col] = x0; conv_out[(i - (C - 3)) * 1536 + col + 1] = x1; }
            float s0 = silu_f(a0), s1 = silu_f(a1);
            if (m < 2) {
                const float ss = wave_sum(s0 * s0 + s1 * s1);
                const float r = rsqrtf(ss + EPS) * (m == 0 ? 0.08838834764831845f : 1.f);
                s0 *= r; s1 *= r;
            }
            *(LAS unsigned*)(lds + dst + i * LD + lane * 4) = pack2(s0, s1);
        }
    }
    if (wave == 0) {
        float gi = 0.f, bi = 0.f;
        if (lane < C) {
            const float bl = bf2f(blr), al = bf2f(alr);
            bi = __builtin_amdgcn_rcpf(1.f + __expf(-bl));
            const float x = al + dtb;
            const float sp = fmaxf(x, 0.f) + __logf(1.f + __expf(-fabsf(x)));
            gi = -__expf(alg) * sp;
        }
        float G = gi;
#pragma unroll
        for (int o = 1; o < 64; o <<= 1) { const float t = __shfl_up(G, o); if (lane >= o) G += t; }
        const float Gl = __shfl(G, C - 1);
        if (lane < C) { sc[lane] = G; sc[64 + lane] = bi; sc[128 + lane] = __expf(G); sc[192 + lane] = __expf(Gl - G); }
        if (lane == 0) p.gtot()[item] = __expf(Gl);
    }
    __syncthreads();
    lds_mm<C, C, 128>(lds, KN, LD, KN, LD, [&](int i0, int j, f32x4 v) {
        const float Gj = sc[j];
        f32x4 o;
#pragma unroll
        for (int e = 0; e < 4; ++e) { const int i = i0 + e; o[e] = (i > j) ? v[e] * __expf(sc[i] - Gj) * sc[64 + i] : 0.f; }
#pragma unroll
        for (int e = 0; e < 4; ++e) *(LAS bf16_t*)(lds + LB + (i0 + e) * LC + j * 2) = f2bf(o[e]);
        if ((i0 >> 4) == (j >> 4)) *(LAS f32x4*)(lds + LM + j * LL + (i0 & 15) * 4) = o;
    });
    lds_mm<C, C, 128>(lds, KN, LD, QN, LD, [&](int j0, int i, f32x4 v) {
        const float Gi = sc[i];
        float o[4];
#pragma unroll
        for (int e = 0; e < 4; ++e) { const int j = j0 + e; o[e] = (i >= j) ? v[e] * __expf(Gi - sc[j]) : 0.f; }
        u32x2 w; w[0] = pack2(o[0], o[1]); w[1] = pack2(o[2], o[3]);
        *(LAS u32x2*)(lds + QK + i * LC + j0 * 2) = w;
    });
    for (int e = tid; e < C * 128; e += NTHR) {
        const int c = e >> 7, a = e & 127;
        const float kv = bf2f(*(const LAS bf16_t*)(lds + KN + c * LD + a * 2));
        *(LAS bf16_t*)(lds + KDT + a * LC + c * 2) = f2bf(kv * sc[192 + c]);
    }
    __syncthreads();
    {
        typedef short s16x4 __attribute__((ext_vector_type(4)));
        const int fr = lane & 15, fq = lane >> 4;
        const bool isU = tid < 128; const int cc = tid & 127;
        const int srcb = (isU ? VV : KN) + cc * 2;
        const int dst = (isU ? UT : WT) + cc * LC;
#pragma unroll 1
        for (int ib = 0; ib < C / 16; ++ib) {
            if (ib > 0) {
#pragma unroll
                for (int t = 0; t < 2; ++t) {
                    const int col = (wave * 2 + t) * 16 + fr;
                    const int xrow = (col < 128 ? UT + col * LC : WT + (col - 128) * LC);
                    f32x4 acc = {0.f, 0.f, 0.f, 0.f};
#pragma unroll 1
                    for (int kb = 0; kb < ib; ++kb) {
                        const s16x4 a = *(const LAS s16x4*)(lds + LB + (ib * 16 + fr) * LC + (kb * 16 + 4 * fq) * 2);
                        const s16x4 bb = *(const LAS s16x4*)(lds + xrow + (kb * 16 + 4 * fq) * 2);
                        acc = __builtin_amdgcn_mfma_f32_16x16x16bf16_1k(a, bb, acc, 0, 0, 0);
                    }
#pragma unroll
                    for (int e = 0; e < 4; ++e) *(LAS float*)(lds + CR + (4 * fq + e) * CRLD + col * 4) = acc[e];
                }
                __syncthreads();
            }
            if (tid < 256) {
                float acc[16];
#pragma unroll
                for (int r = 0; r < 16; ++r) {
                    const int i = ib * 16 + r;
                    const float src = bf2f(*(const LAS bf16_t*)(lds + srcb + i * LD));
                    acc[r] = isU ? src * sc[64 + i] : src * sc[64 + i] * sc[128 + i];
                    if (ib > 0) acc[r] -= *(const LAS float*)(lds + CR + r * CRLD + tid * 4);
                }
#pragma unroll
                for (int r2 = 0; r2 < 15; ++r2) {
                    f32x4 lq[4];
#pragma unroll
                    for (int q = 0; q < 4; ++q) lq[q] = *(const LAS f32x4*)(lds + LM + (ib * 16 + r2) * LL + q * 16);
#pragma unroll
                    for (int r = r2 + 1; r < 16; ++r) acc[r] -= lq[r >> 2][r & 3] * acc[r2];
                }
#pragma unroll
                for (int r = 0; r < 16; r += 2) *(LAS unsigned*)(lds + dst + (ib * 16 + r) * 2) = pack2(acc[r], acc[r + 1]);
            }
            __syncthreads();
        }
    }
#ifdef PROBE_PROD
    for (int prb = 0; prb < 2; ++prb) {
#endif
    bf16_t* An = p.Aneg() + (size_t)item * 16384;
    bf16_t* Bt = p.BT() + (size_t)item * 16384;
    bf16_t* Qp = p.Qp() + (size_t)item * 8192;
    bf16_t* Op = p.Op() + (size_t)item * 8192;
    lds_mm<128, 128, C>(lds, WT, LC, KDT, LC, [&](int b0, int a, f32x4 v) {
        u32x2 w; w[0] = pack2(-v[0], -v[1]); w[1] = pack2(-v[2], -v[3]);
        *(u32x2*)(An + a * 128 + permcol(b0)) = w;
    });
    lds_mm<128, 128, C>(lds, KDT, LC, UT, LC, [&](int a0, int vv, f32x4 v) {
        u32x2 w; w[0] = pack2(v[0], v[1]); w[1] = pack2(v[2], v[3]);
        *(u32x2*)(Bt + vv * 128 + a0) = w;
    });
    lds_mm<128, C, C>(lds, WT, LC, QK, LC, [&](int b0, int i, f32x4 v) {
        const u32x2 q = *(const LAS u32x2*)(lds + QN + i * LD + b0 * 2);
        const float eg = sc[128 + i];
        u32x2 w; w[0] = pack2(lo2f(q[0]) * eg - v[0], hi2f(q[0]) * eg - v[1]); w[1] = pack2(lo2f(q[1]) * eg - v[2], hi2f(q[1]) * eg - v[3]);
        *(u32x2*)(Qp + i * 128 + b0) = w;
    });
    lds_mm<128, C, C>(lds, UT, LC, QK, LC, [&](int v0, int i, f32x4 v) {
        u32x2 w; w[0] = pack2(v[0], v[1]); w[1] = pack2(v[2], v[3]);
        *(u32x2*)(Op + i * 128 + v0) = w;
    });
#ifdef PROBE_PROD
    }
#endif
    if (flag) {
        asm volatile("s_waitcnt vmcnt(0)" ::: "memory");
        __syncthreads();
        if (tid == 0) {
            __builtin_amdgcn_fence(__ATOMIC_RELEASE, "agent");
            asm volatile("s_waitcnt vmcnt(0)" ::: "memory");
            __hip_atomic_store(flag, 1u, __ATOMIC_RELAXED, __HIP_MEMORY_SCOPE_AGENT);
        }
    }
    __syncthreads();
}

DI void rope16(float (&x)[16], int pos) {
#pragma unroll
    for (int i = 0; i < 8; ++i) {
        const float inv = exp2f(-(float)i * 2.3664460711f);
        const float ang = (float)pos * inv;
        const float k = rintf(ang * 0.15915494309189535f);
        float r = fmaf(-k, 6.2831854820251465f, ang); r = fmaf(-k, -1.7484555314695172e-07f, r);
        const float cs = __cosf(r), sn = __sinf(r);
        const float x1 = x[i], x2 = x[i + 8];
        x[i] = x1 * cs - x2 * sn; x[i + 8] = x2 * cs + x1 * sn;
    }
}

template <int NQ, int NK>
DI void swa_item(const Params& p, int l, int kvh, int qrow0, int qpos0, int krow0  , int kpos0, int ncache,
                 const float* ck, const float* cv, float* outk, float* outv, int out_from  , LAS unsigned char* lds, int g0 = 0, int g1 = 4) {
    constexpr int LK = 144, LVT = (NK + 8) * 2, LQ = 144, LS = (NK + 4) * 4;
    constexpr int KL = 0, VT = KL + NK * LK, QL = VT + 64 * LVT, SCo = QL + 4 * NQ * LQ;
    static_assert(SCo + NQ * LS <= LDS_BYTES, "lds");
    const int tid = tid_opaque(), wave = tid >> 6, lane = tid & 63;
    const bf16_t* pb = p.pbuf();
    const float sk0 = p.sinks[l * 8 + kvh * 4], sk1 = p.sinks[l * 8 + kvh * 4 + 1], sk2 = p.sinks[l * 8 + kvh * 4 + 2], sk3 = p.sinks[l * 8 + kvh * 4 + 3];
    constexpr int NQI = 4 * NQ * 4 / NTHR, NKI = (NK * 4 + NTHR - 1) / NTHR;
    u32x4 qr[NQI][2], kr[NKI][2], vr[NKI][2];
#pragma unroll
    for (int it = 0; it < NQI; ++it) {
        const int e = tid + it * NTHR, g = e / (NQ * 4), i = (e >> 2) % NQ, part = e & 3;
        const bf16_t* sp = pb + (size_t)(qrow0 + i) * LDP + 2056 + (kvh * 4 + g) * 64 + part * 16;
        qr[it][0] = *(const u32x4*)sp; qr[it][1] = *(const u32x4*)(sp + 8);
    }
#pragma unroll
    for (int it = 0; it < NKI; ++it) {
        const int e = tid + it * NTHR, j = e >> 2, part = e & 3, prow = krow0 + j;
        kr[it][0] = (u32x4){0u, 0u, 0u, 0u}; kr[it][1] = kr[it][0]; vr[it][0] = kr[it][0]; vr[it][1] = kr[it][0];
        if (e < NK * 4 && j >= ncache && prow >= 0) {
            const bf16_t* sk = pb + (size_t)prow * LDP + 2568 + kvh * 64 + part * 16; const bf16_t* sv = pb + (size_t)prow * LDP + 2696 + kvh * 64 + part * 16;
            kr[it][0] = *(const u32x4*)sk; kr[it][1] = *(const u32x4*)(sk + 8); vr[it][0] = *(const u32x4*)sv; vr[it][1] = *(const u32x4*)(sv + 8);
        }
    }
#pragma unroll
    for (int it = 0; it < NQI; ++it) {
        const int e = tid + it * NTHR, g = e / (NQ * 4), i = (e >> 2) % NQ, part = e & 3;
        float qx[16];
#pragma unroll
        for (int q = 0; q < 4; ++q) { qx[2 * q] = lo2f(qr[it][0][q]); qx[2 * q + 1] = hi2f(qr[it][0][q]); qx[8 + 2 * q] = lo2f(qr[it][1][q]); qx[8 + 2 * q + 1] = hi2f(qr[it][1][q]); }
        if (part == 0) rope16(qx, qpos0 + i);
#pragma unroll
        for (int d = 0; d < 16; d += 2) *(LAS unsigned*)(lds + QL + (g * NQ + i) * LQ + (part * 16 + d) * 2) = pack2(qx[d], qx[d + 1]);
    }
#pragma unroll
    for (int it = 0; it < NKI; ++it) {
        const int e = tid + it * NTHR, j = e >> 2, part = e & 3;
        if (e < NK * 4) {
            float kx[16], vx[16];
            if (j < ncache) {
                const float* s = ck + ((size_t)j * 2 + kvh) * 64 + part * 16; const float* s2 = cv + ((size_t)j * 2 + kvh) * 64 + part * 16;
#pragma unroll
                for (int d = 0; d < 16; d += 4) { const f32x4 a4 = *(const f32x4*)(s + d), b4 = *(const f32x4*)(s2 + d);
#pragma unroll
                    for (int q = 0; q < 4; ++q) { kx[d + q] = a4[q]; vx[d + q] = b4[q]; } }
            } else {
#pragma unroll
                for (int q = 0; q < 4; ++q) { kx[2 * q] = lo2f(kr[it][0][q]); kx[2 * q + 1] = hi2f(kr[it][0][q]); kx[8 + 2 * q] = lo2f(kr[it][1][q]); kx[8 + 2 * q + 1] = hi2f(kr[it][1][q]);
                                              vx[2 * q] = lo2f(vr[it][0][q]); vx[2 * q + 1] = hi2f(vr[it][0][q]); vx[8 + 2 * q] = lo2f(vr[it][1][q]); vx[8 + 2 * q + 1] = hi2f(vr[it][1][q]); }
                if (part == 0) rope16(kx, kpos0 + j);
            }
            if (outk && j >= out_from) {
                float* ok = outk + ((size_t)(j - out_from) * 2 + kvh) * 64 + part * 16; float* ov = outv + ((size_t)(j - out_from) * 2 + kvh) * 64 + part * 16;
#pragma unroll
                for (int d = 0; d < 16; d += 4) { *(f32x4*)(ok + d) = (f32x4){kx[d], kx[d + 1], kx[d + 2], kx[d + 3]}; *(f32x4*)(ov + d) = (f32x4){vx[d], vx[d + 1], vx[d + 2], vx[d + 3]}; }
            }
#pragma unroll
            for (int d = 0; d < 16; d += 2) *(LAS unsigned*)(lds + KL + j * LK + (part * 16 + d) * 2) = pack2(kx[d], kx[d + 1]);
#pragma unroll
            for (int d = 0; d < 16; ++d) *(LAS bf16_t*)(lds + VT + (part * 16 + d) * LVT + j * 2) = f2bf(vx[d]);
        }
    }
    __syncthreads();
    for (int g = g0; g < g1; ++g) {
        const int head = kvh * 4 + g;
        lds_mm<NK, NQ, 64>(lds, KL, LK, QL + g * NQ * LQ, LQ, [&](int j0, int i, f32x4 v) {
            f32x4 o;
#pragma unroll
            for (int e = 0; e < 4; ++e) { const int j = j0 + e; o[e] = (j >= ncache && krow0 + j < 0) ? -INFINITY : v[e] * 0.125f; }
            *(LAS f32x4*)(lds + SCo + i * LS + j0 * 4) = o;
        });
        __syncthreads();
        const float sk = g == 0 ? sk0 : (g == 1 ? sk1 : (g == 2 ? sk2 : sk3));
        for (int i = wave; i < NQ; i += 8) {
            float sv[(NK + 63) / 64]; float mx = sk;
#pragma unroll
            for (int t = 0; t < (NK + 63) / 64; ++t) { const int j = lane + 64 * t; sv[t] = (j < NK) ? *(const LAS float*)(lds + SCo + i * LS + j * 4) : -INFINITY; mx = fmaxf(mx, sv[t]); }
            mx = wave_max(mx);
            float sum = 0.f;
#pragma unroll
            for (int t = 0; t < (NK + 63) / 64; ++t) { sv[t] = __expf(sv[t] - mx); sum += sv[t]; }
            sum = wave_sum(sum) + __expf(sk - mx);
            const float inv = __builtin_amdgcn_rcpf(sum);
#pragma unroll
            for (int t = 0; t < (NK + 63) / 64; ++t) { const int j = lane + 64 * t; if (j < NK) *(LAS bf16_t*)(lds + SCo + i * LS + j * 2) = f2bf(sv[t] * inv); }
        }
        __syncthreads();
        lds_mm<64, NQ, NK>(lds, VT, LVT, SCo, LS, [&](int d0, int i, f32x4 v) {
            u32x2 w; w[0] = pack2(v[0], v[1]); w[1] = pack2(v[2], v[3]);
            *(u32x2*)(p.xb() + (size_t)(qrow0 + i) * DM + 512 + head * 64 + d0) = w;
        });
        __syncthreads();
    }
}

DI void scan_run(const Params& p, LAS unsigned char* lds, int item0, int istride, const float* S0, float* Sout, int slice, unsigned* flags  ) {
    const int tid = tid_opaque(), wave = tid >> 6, lane = tid & 63, fr = lane & 15, fq = lane >> 4;
    constexpr int BUF = 128 * 272, SLOT = 2 * BUF, D = 6, n = NCH;
    const bool cw = wave < 4;
    const int tl = tid & 255;
    auto gload = [&](u32x4 (&R)[8], int step) {
        const bf16_t* src = p.Aneg() + (size_t)(item0 + step * istride) * 16384;
#pragma unroll
        for (int i = 0; i < 8; ++i) { const int q = tl + 256 * i; R[i] = *(const u32x4*)(src + (q >> 4) * 128 + (q & 15) * 8); }
    };
    auto lstore = [&](const u32x4 (&R)[8], int buf) {
#pragma unroll
        for (int i = 0; i < 8; ++i) { const int q = tl + 256 * i; *(LAS u32x4*)(lds + buf * BUF + (q >> 4) * 272 + (q & 15) * 16) = R[i]; }
    };
    const size_t lofs = (size_t)(slice * 16 + fr) * 128 + 4 * fq + 32 * (wave & 3);
    f32x4 S[2];
#pragma unroll
    for (int t = 0; t < 2; ++t) {
        if (S0) { for (int j = 0; j < 4; ++j) S[t][j] = S0[(32 * (wave & 3) + 16 * t + 4 * fq + j) * 128 + slice * 16 + fr]; }
        else { float z = 0.f; asm volatile("" : "+v"(z)); S[t] = (f32x4){z, z, z, z}; }
    }
    auto publish = [&](int sb, int step) {
        u32x4 w4; w4[0] = pack2(S[0][0], S[0][1]); w4[1] = pack2(S[0][2], S[0][3]); w4[2] = pack2(S[1][0], S[1][1]); w4[3] = pack2(S[1][2], S[1][3]);
        *(LAS u32x4*)(lds + SLOT + ((sb * 4 + wave) * 64 + lane) * 16) = w4;
        const size_t it = step < n ? (size_t)(item0 + step * istride) : (size_t)N_ITEM;
        bf16_t* st = p.ST() + it * 16384 + lofs;
        u32x2 lo; lo[0] = w4[0]; lo[1] = w4[1]; u32x2 hi; hi[0] = w4[2]; hi[1] = w4[3];
        *(u32x2*)st = lo; *(u32x2*)(st + 16) = hi;
    };
    auto loadB = [&](u32x2 (&B)[2], float& g, int step) {
        const size_t it = (size_t)(item0 + step * istride);
        g = p.gtot()[it];
        B[0] = *(const u32x2*)(p.BT() + it * 16384 + lofs); B[1] = *(const u32x2*)(p.BT() + it * 16384 + lofs + 16);
    };
    auto compute = [&](const u32x2 (&B)[2], float g, int step, int buf) {
        const int sbc = step & 1;
        bf16x8 Sb[4], Af[4][2];
#pragma unroll
        for (int s = 0; s < 4; ++s) Sb[s] = *(const LAS bf16x8*)(lds + SLOT + ((sbc * 4 + s) * 64 + lane) * 16);
#pragma unroll
        for (int s = 0; s < 4; ++s)
#pragma unroll
            for (int t = 0; t < 2; ++t) Af[s][t] = *(const LAS bf16x8*)(lds + buf * BUF + (16 * (2 * wave + t) + fr) * 272 + (32 * s + 8 * fq) * 2);
        f32x4 acc[2];
#pragma unroll
        for (int t = 0; t < 2; ++t) { acc[t][0] = g * S[t][0] + lo2f(B[t][0]); acc[t][1] = g * S[t][1] + hi2f(B[t][0]); acc[t][2] = g * S[t][2] + lo2f(B[t][1]); acc[t][3] = g * S[t][3] + hi2f(B[t][1]); }
        asm volatile("s_waitcnt lgkmcnt(0)" ::: "memory");
#pragma unroll
        for (int s = 0; s < 4; ++s)
#pragma unroll
            for (int t = 0; t < 2; ++t) acc[t] = __builtin_amdgcn_mfma_f32_16x16x32_bf16(Af[s][t], Sb[s], acc[t], 0, 0, 0);
        S[0] = acc[0]; S[1] = acc[1];
        publish(sbc ^ 1, step + 1);
    };
    int ready = 0;
    auto ensure = [&](int need) {
        while (ready < need) {
            unsigned sp = 0;
            for (;;) {
                const int c = ready + (lane & 31);
                const unsigned f = c < n ? __hip_atomic_load(flags + (size_t)c * istride, __ATOMIC_RELAXED, __HIP_MEMORY_SCOPE_AGENT) : 1u;
                if ((__builtin_amdgcn_ballot_w64(f != 0u) & 0xffffffffull) == 0xffffffffull) break;
                __builtin_amdgcn_s_sleep(2);
                if (++sp > (1u << 22)) break;
            }
            __builtin_amdgcn_fence(__ATOMIC_ACQUIRE, "agent");
            asm volatile("s_waitcnt vmcnt(0)" ::: "memory");
            ready += 32;
        }
    };
    if (wave == 4) ensure(D + 3 < n ? D + 3 : n);
    __syncthreads();
    if (cw) {
        u32x2 Bv[D][2]; float gv[D];
#pragma unroll
        for (int k = 0; k < D; ++k) loadB(Bv[k], gv[k], k);
        publish(0, 0);
        lds_barrier();
        int c0 = 0;
        for (; c0 + D <= n; c0 += D) {
#pragma unroll
            for (int k = 0; k < D; ++k) { const int c = c0 + k; compute(Bv[k], gv[k], c, c & 1); loadB(Bv[k], gv[k], c + D < n ? c + D : n - 1); lds_barrier(); }
        }
#pragma unroll
        for (int k = 0; k < n % D; ++k) { const int c = c0 + k; compute(Bv[k], gv[k], c, c & 1); lds_barrier(); }
    } else {
        u32x4 RR[D][8];
        { u32x4 Rt[8]; gload(Rt, 0); lstore(Rt, 0); }
#pragma unroll
        for (int k = 0; k < D; ++k) gload(RR[(k + 1) % D], k + 1);
        lds_barrier();
        int c0 = 0;
        for (; c0 + D <= n; c0 += D) {
#pragma unroll
            for (int k = 0; k < D; ++k) {
                const int c = c0 + k;
                lstore(RR[(k + 1) % D], (c + 1) & 1); gload(RR[(k + 1) % D], c + 1 + D < n ? c + 1 + D : n - 1);
                if (wave == 4) ensure(c + D + 4 < n ? c + D + 4 : n);
                lds_barrier();
            }
        }
#pragma unroll
        for (int k = 0; k < n % D; ++k) { const int c = c0 + k; lstore(RR[(k + 1) % D], (c + 1) & 1); lds_barrier(); }
    }
    __syncthreads();
    if (cw) {
#pragma unroll
        for (int t = 0; t < 2; ++t)
#pragma unroll
            for (int j = 0; j < 4; ++j) Sout[(32 * wave + 16 * t + 4 * fq + j) * 128 + slice * 16 + fr] = S[t][j];
    }
}

DI void scan_single(const Params& p, LAS unsigned char* lds, int item, const float* S0, float* Sout) {
    constexpr int LD = 272, AL = 0, S0T = AL + 128 * LD;
    const int tid = tid_opaque();
    const bf16_t* An = p.Aneg() + (size_t)item * 16384;
    bf16_t* ST = p.ST() + (size_t)item * 16384;
    {
        u32x4 av[4]; f32x4 sv[8];
#pragma unroll
        for (int i = 0; i < 4; ++i) { const int q = tid + NTHR * i; av[i] = *(const u32x4*)(An + (q >> 4) * 128 + (q & 15) * 8); }
#pragma unroll
        for (int i = 0; i < 8; ++i) { const int q = tid + NTHR * i; sv[i] = *(const f32x4*)(S0 + (q >> 5) * 128 + (q & 31) * 4); }
#pragma unroll
        for (int i = 0; i < 4; ++i) { const int q = tid + NTHR * i; *(LAS u32x4*)(lds + AL + (q >> 4) * LD + (q & 15) * 16) = av[i]; }
#pragma unroll
        for (int i = 0; i < 8; ++i) {
            const int q = tid + NTHR * i, k = q >> 5, v0 = (q & 31) * 4, pk = permcol(k);
#pragma unroll
            for (int e = 0; e < 4; ++e) { const bf16_t b = f2bf(sv[i][e]); *(LAS bf16_t*)(lds + S0T + (v0 + e) * LD + pk * 2) = b; ST[(v0 + e) * 128 + k] = b; }
        }
    }
    __syncthreads();
    const float g = p.gtot()[item];
    const bf16_t* Bt = p.BT() + (size_t)item * 16384;
    lds_mm<128, 128, 128>(lds, AL, LD, S0T, LD, [&](int a0, int v, f32x4 c) {
        const u32x2 b = *(const u32x2*)(Bt + v * 128 + a0);
        const float bb[4] = {lo2f(b[0]), hi2f(b[0]), lo2f(b[1]), hi2f(b[1])};
#pragma unroll
        for (int e = 0; e < 4; ++e) Sout[(a0 + e) * 128 + v] = g * S0[(a0 + e) * 128 + v] + bb[e] + c[e];
    });
    __syncthreads();
}

template <int C>
DI void gdn_out(const Params& p, int l, int item, int h, int row0, LAS unsigned char* lds) {
    constexpr int LD = 272, QP = 0, STL = QP + C * LD, OPL = STL + 128 * LD, ZL = OPL + C * LD, OB = ZL + C * LD, LO = 132 * 4;
    static_assert(OB + C * LO <= LDS_BYTES, "lds");
    const int tid = tid_opaque(), wave = tid >> 6, lane = tid & 63;
    const bf16_t* Qp = p.Qp() + (size_t)item * 8192; const bf16_t* ST = p.ST() + (size_t)item * 16384; const bf16_t* Op = p.Op() + (size_t)item * 8192;
    const float gw0 = p.gnorm_w[l * 128 + 2 * lane], gw1 = p.gnorm_w[l * 128 + 2 * lane + 1];
    {
        constexpr int N1 = C * 16 / NTHR;
        u32x4 q[N1], o[N1], z[N1], st[4];
#pragma unroll
        for (int it = 0; it < N1; ++it) { const int e = tid + it * NTHR, r = e >> 4, c8 = e & 15;
            q[it] = *(const u32x4*)(Qp + r * 128 + c8 * 8); o[it] = *(const u32x4*)(Op + r * 128 + c8 * 8);
            z[it] = *(const u32x4*)(p.pbuf() + (size_t)(row0 + r) * LDP + 1536 + h * 128 + c8 * 8); }
#pragma unroll
        for (int it = 0; it < 4; ++it) { const int e = tid + it * NTHR, r = e >> 4, c8 = e & 15; st[it] = *(const u32x4*)(ST + r * 128 + c8 * 8); }
#pragma unroll
        for (int it = 0; it < N1; ++it) { const int e = tid + it * NTHR, r = e >> 4, c8 = e & 15;
            *(LAS u32x4*)(lds + QP + r * LD + c8 * 16) = q[it]; *(LAS u32x4*)(lds + OPL + r * LD + c8 * 16) = o[it]; *(LAS u32x4*)(lds + ZL + r * LD + c8 * 16) = z[it]; }
#pragma unroll
        for (int it = 0; it < 4; ++it) { const int e = tid + it * NTHR, r = e >> 4, c8 = e & 15; *(LAS u32x4*)(lds + STL + r * LD + c8 * 16) = st[it]; }
    }
    __syncthreads();
    lds_mm<128, C, 128>(lds, STL, LD, QP, LD, [&](int v0, int i, f32x4 v) {
        const u32x2 o = *(const LAS u32x2*)(lds + OPL + i * LD + v0 * 2);
        f32x4 r; r[0] = v[0] + lo2f(o[0]); r[1] = v[1] + hi2f(o[0]); r[2] = v[2] + lo2f(o[1]); r[3] = v[3] + hi2f(o[1]);
        *(LAS f32x4*)(lds + OB + i * LO + v0 * 4) = r;
    });
    __syncthreads();
    for (int i = wave; i < C; i += 8) {
        const float o0 = *(const LAS float*)(lds + OB + i * LO + lane * 8), o1 = *(const LAS float*)(lds + OB + i * LO + lane * 8 + 4);
        const float ss = wave_sum(o0 * o0 + o1 * o1);
        const float r = rsqrtf(ss * (1.f / 128.f) + EPS);
        const unsigned zu = *(const LAS unsigned*)(lds + ZL + i * LD + lane * 4);
        const float y0 = o0 * r * gw0 * silu_f(lo2f(zu)), y1 = o1 * r * gw1 * silu_f(hi2f(zu));
        *(unsigned*)(p.xb() + (size_t)(row0 + i) * DM + h * 128 + 2 * lane) = pack2(y0, y1);
    }
    __syncthreads();
}

#if defined(DUP_PHASE) && (DUP_PHASE == 2 || DUP_PHASE == 11)
#define HALFSCALE(s) ((s) == DUP_PHASE ? (rep ? 0.5f : 0.0f) : 0.5f)
#else
#define HALFSCALE(s) 0.5f
#endif
#if defined(DUP_PHASE) && DUP_PHASE == 8
#define ONESCALE 0.5f
#else
#define ONESCALE 1.0f
#endif
constexpr int PH_PER_LAYER = 11;
constexpr int N_PHASE = DEPTH * PH_PER_LAYER + 1;

DI void sample_stage_a(const Params& p, int l, LAS unsigned char* lds, int tr, unsigned& tgt) {
    unsigned* cnt = p.bar() + XCD_BAR_WORDS;
    { pg8::SplitKOrder S{4, 11, 256, TEAM, tr};
      pg8::gemm_phase(lds, pg8::Gemm{p.act_s(), p.w_ffout1(), 256, DM, 256, DFF}, S, pg8::EpiPartial{p.part()}); }
    team_barrier(cnt, tgt);
    norm_phase(p.xres(), nullptr, p.xres(), p.norm_mix + l * DM, p.xb(), nullptr, T_P, T_ALL, tr, TEAM, p.part());
    team_barrier(cnt, tgt);
    { pg8::StaticOrder S; S.init(256, LDP, TEAM, tr);
      pg8::gemm_phase(lds, pg8::Gemm{p.xb() + (size_t)T_P * DM, p.w_mixin(), 256, LDP, DM, DM}, S, pg8::EpiBf16{p.pbuf(), LDP, T_P}); }
}
DI void sample_stage_b(const Params& p, int l, LAS unsigned char* lds, int tr, unsigned& tgt) {
    unsigned* cnt = p.bar() + XCD_BAR_WORDS;
#ifdef PROBE_TEAM_MIX
    for (int prb = 0; prb < 2; ++prb) {
#endif
    {
        const int sidx = tr >> 2, h = tr & 3;
        gdn_prep<32>(p, l, NCH * 4 + tr, h, T_P + sidx * 32, p.cache_conv + (size_t)(l * 8 + sidx) * 3 * 1536, false, p.out + O_CONVS + (size_t)(l * 8 + sidx) * 3 * 1536, lds);
        {
            const int s2 = tr >> 2, kvh = (tr >> 1) & 1, gh = (tr & 1) * 2;
            swa_item<32, 160>(p, l, kvh, T_P + s2 * 32, 4096, T_P + s2 * 32 - 128, 4096 - 128, 128,
                              p.cache_k + (size_t)(l * 8 + s2) * 128 * 128, p.cache_v + (size_t)(l * 8 + s2) * 128 * 128,
                              p.out + O_KS + (size_t)(l * 8 + s2) * 128 * 128, p.out + O_VS + (size_t)(l * 8 + s2) * 128 * 128, 32, lds, gh, gh + 2);
        }
    }
    asm volatile("s_waitcnt vmcnt(0)" ::: "memory"); __syncthreads();
    scan_single(p, lds, NCH * 4 + tr, p.state_delta + (size_t)(l * 32 + tr) * 16384, p.out + O_DELTAS + (size_t)(l * 32 + tr) * 16384);
    asm volatile("s_waitcnt vmcnt(0)" ::: "memory"); __syncthreads();
    gdn_out<32>(p, l, NCH * 4 + tr, tr & 3, T_P + (tr >> 2) * 32, lds);
#ifdef PROBE_TEAM_MIX
    }
#endif
    team_barrier(cnt, tgt);
    { pg8::SplitKOrder SK{4, 4, 256, TEAM, tr};
      pg8::gemm_phase(lds, pg8::Gemm{p.xb() + (size_t)T_P * DM, p.w_mixout(), 256, DM, 256, DM}, SK, pg8::EpiPartial{p.part()}); }
    team_barrier(cnt, tgt);
    norm_phase(p.xres(), nullptr, p.xres(), p.norm_ff2 + l * DM, p.xb(), nullptr, T_P, T_ALL, tr, TEAM, p.part(), 4, 1.0f);
}

__global__ void __launch_bounds__(NTHR) fwd_megakernel(Params p) {
    extern __shared__ __attribute__((aligned(16))) unsigned char shm[];
    LAS unsigned char* lds = (LAS unsigned char*)shm;
    cg::grid_group grid = cg::this_grid();
    const int bid = blockIdx.x, nblk = gridDim.x;
    volatile LAS unsigned* xst = (volatile LAS unsigned*)(lds + LDS_BYTES - 16);
    if (threadIdx.x == 0) { xst[0] = 0u; xst[1] = 0u; }
    __syncthreads();
    const XcdBarrier xbar = xcd_barrier_post(p.bar(), xst);
    const int nwk = nblk - TEAM;
    const bool team = bid >= nwk; const int tr = bid - nwk;
    unsigned tgt = 0u;
    LAS unsigned char* const lds0 = lds;
    for (int ph = p.phase_lo; ph <= p.phase_hi; ++ph) {
        if (ph == p.phase_lo + 1) grid.sync(); else if (ph > p.phase_lo) xcd_barrier(xbar);
        { unsigned lv = (unsigned)(size_t)lds0; asm volatile("" : "+s"(lv)); lds = (LAS unsigned char*)(size_t)lv; }
#ifdef DUP_PHASE
        for (int rep = 0; rep < ((ph % PH_PER_LAYER) == DUP_PHASE && ph != N_PHASE - 1 ? 2 : 1); ++rep) {
        if (rep) xcd_barrier(xbar);
#endif
        if (ph == N_PHASE - 1) { norm_phase(p.xres(), nullptr, nullptr, p.norm_final, nullptr, p.out + O_Y, 0, T_ALL, bid, nblk, p.part()); break; }
        const int l = ph / PH_PER_LAYER, s = ph % PH_PER_LAYER;
        switch (s) {
        case 0: {
            if (l == 0) {
                convert_w(p.ff1_w_in, DM, 2 * DFF, p.w_ffin1(), 2 * DFF, 1, lds, bid, nblk);
                convert_w(p.ff1_w_out, DFF, DM, p.w_ffout1(), DM, 0, lds, bid, nblk);
                convert_w(p.w_mix_in, DM, DIN, p.w_mixin(), LDP, 0, lds, bid, nblk);
            }
            convert_w(p.w_mix_out + (size_t)l * DM * DM, DM, DM, p.w_mixout(), DM, 0, lds, bid, nblk);
            convert_w(p.ff2_w_in + (size_t)l * DM * 2 * DFF, DM, 2 * DFF, p.w_ffin2(), 2 * DFF, 1, lds, bid, nblk);
            convert_w(p.ff2_w_out + (size_t)l * DFF * DM, DFF, DM, p.w_ffout2(), DM, 0, lds, bid, nblk);
            if (l == 0) norm_phase(p.x_prompt, p.x_sample, p.xres(), p.norm_ff1, p.xb(), nullptr, 0, T_ALL, bid, nblk);
            else norm_phase(p.xres(), nullptr, p.xres(), p.norm_ff1 + l * DM, p.xb(), nullptr, 0, T_ALL, bid, nblk, p.part());
        } break;
        case 1: case 9: {
            const int Mrows = T_ALL;
            pg8::StaticOrder S; S.init(Mrows, 2 * DFF, nblk, bid);
            pg8::gemm_phase(lds, pg8::Gemm{p.xb(), s == 1 ? p.w_ffin1() : p.w_ffin2(), Mrows, 2 * DFF, DM, DM}, S, pg8::EpiSwiglu{p.act(), 0, p.act_s()});
        } break;
        case 2: case 10: {
            pg8::StaticOrder S; S.init(T_P, DM, nblk, bid);
#ifdef PROBE_FFOUT
            for (int prb = 0; prb < 2; ++prb) {
                if (prb) xcd_barrier(xbar);
                pg8::gemm_phase(lds, pg8::Gemm{p.act(), s == 2 ? p.w_ffout1() : p.w_ffout2(), T_P, DM, DFF, DFF}, S, pg8::EpiResid{p.xres(), 0.25f, 0});
            }
#else
            pg8::gemm_phase(lds, pg8::Gemm{p.act(), s == 2 ? p.w_ffout1() : p.w_ffout2(), T_P, DM, DFF, DFF}, S, pg8::EpiResid{p.xres(), 0.5f, 0});
#endif
            if (s != 2 && bid < 44) {
                pg8::SplitKOrder SK{4, 11, 256, 44, bid};
                pg8::gemm_phase(lds, pg8::Gemm{p.act_s(), p.w_ffout2(), 256, DM, 256, DFF}, SK, pg8::EpiPartial{p.part()});
            }
        } break;
        case 3: norm_phase(p.xres(), nullptr, nullptr, p.norm_mix + l * DM, p.xb(), nullptr, 0, T_P, bid, nblk); break;
        case 4: {
            pg8::StaticOrder S; S.init(T_P, LDP, nblk, bid);
            pg8::gemm_phase(lds, pg8::Gemm{p.xb(), p.w_mixin(), T_P, LDP, DM, DM}, S, pg8::EpiBf16{p.pbuf(), LDP, 0});
        } break;
        case 5: {
            if (team) {
                sample_stage_a(p, l, lds, tr, tgt); team_barrier(p.bar() + XCD_BAR_WORDS, tgt); sample_stage_b(p, l, lds, tr, tgt);
                if (l + 1 < DEPTH) {
                    convert_w(p.ff1_w_in + (size_t)(l + 1) * DM * 2 * DFF, DM, 2 * DFF, p.w_ffin1(), 2 * DFF, 1, lds, tr, TEAM);
                    convert_w(p.ff1_w_out + (size_t)(l + 1) * DFF * DM, DFF, DM, p.w_ffout1(), DM, 0, lds, tr, TEAM);
                    convert_w(p.w_mix_in + (size_t)(l + 1) * DM * DIN, DM, DIN, p.w_mixin(), LDP, 0, lds, tr, TEAM);
                }
                break;
            }
            unsigned* flags_l = p.bar() + XCD_BAR_WORDS + 64 + l * 1024;
            const int nprep = nwk - 32;
            int a0, astep, aend;
            if ((bid < 64) && ((bid & 7) < 4)) {
                const int h = bid & 7, slice = bid >> 3;
                scan_run(p, lds, h, 4, nullptr, p.out + O_DELTAP + (size_t)(l * 4 + h) * 16384, slice, flags_l + h);
                a0 = 0; astep = 1; aend = 0;
            } else {
                const int rank = bid < 64 ? (bid >> 3) * 4 + (bid & 7) - 4 : bid - 32;
                for (int w = rank; w < NCH * 4; w += nprep) {
                    const int c = w >> 2, h = w & 3;
                    gdn_prep<64>(p, l, w, h, c * 64, nullptr, true, c == NCH - 1 ? p.out + O_CONVP + (size_t)l * 3 * 1536 : nullptr, lds, flags_l + w);
                }
                if (nprep == 192) { if (rank < 64) { a0 = rank; astep = 64; aend = 128; } else { a0 = 128 + (rank - 64); astep = 128; aend = NCH * 2; } }
                else { a0 = rank; astep = nprep; aend = NCH * 2; }
            }
            for (int a = a0; a < aend; a += astep) {
                const int c = a >> 1, kvh = a & 1;
                const bool last = (c == NCH - 1);
                swa_item<64, 192>(p, l, kvh, c * 64, c * 64, (c - 2) * 64, (c - 2) * 64, 0, nullptr, nullptr,
                                  last ? p.out + O_KP + (size_t)l * 128 * 128 : nullptr, last ? p.out + O_VP + (size_t)l * 128 * 128 : nullptr, 64, lds);
            }
        } break;
        case 6: {
            for (int w = bid; w < NCH * 4; w += nblk) gdn_out<64>(p, l, w, w & 3, (w >> 2) * 64, lds);
        } break;
        case 7: {
            pg8::StaticOrder S; S.init(T_P, DM, nblk, bid);
            pg8::gemm_phase(lds, pg8::Gemm{p.xb(), p.w_mixout(), T_P, DM, DM, DM}, S, pg8::EpiResid{p.xres(), 1.0f, 0});
        } break;
        case 8: norm_phase(p.xres(), nullptr, nullptr, p.norm_ff2 + l * DM, p.xb(), nullptr, 0, T_P, bid, nblk); break;
        }
#ifdef DUP_PHASE
        }
#endif
    }
}

extern "C" void kernel_launch(void* const* d_in, const int* in_sizes, int n_in, void* d_out, int out_size, void* d_ws, size_t ws_size, hipStream_t stream) {
    static int grid_blocks = 0;
    if (!grid_blocks) {
        hipFuncSetAttribute((const void*)fwd_megakernel, hipFuncAttributeMaxDynamicSharedMemorySize, LDS_BYTES);
        int dev = 0, cus = 0, per_cu = 0;
        hipGetDevice(&dev);
        hipDeviceGetAttribute(&cus, hipDeviceAttributeMultiprocessorCount, dev);
        hipOccupancyMaxActiveBlocksPerMultiprocessor(&per_cu, fwd_megakernel, NTHR, LDS_BYTES);
        if (per_cu < 1) per_cu = 1;
        grid_blocks = cus;
        if (grid_blocks > 256) grid_blocks = 256;
    }
    Params p{};
    const float* const* in = (const float* const*)d_in;
    p.x_prompt = in[0]; p.x_sample = in[1]; p.cache_conv = in[2]; p.state_delta = in[3]; p.cache_k = in[4]; p.cache_v = in[5];
    p.norm_ff1 = in[6]; p.ff1_w_in = in[7]; p.ff1_w_out = in[8]; p.norm_mix = in[9]; p.w_mix_in = in[10]; p.conv_w = in[11]; p.a_log = in[12]; p.dt_bias = in[13];
    p.gnorm_w = in[14]; p.sinks = in[15]; p.w_mix_out = in[16]; p.norm_ff2 = in[17]; p.ff2_w_in = in[18]; p.ff2_w_out = in[19]; p.norm_final = in[20];
    p.out = (float*)d_out;
    p.ws = (char*)d_ws;
    if (WS_NEED > ws_size) fprintf(stderr, "workspace too small: need %zu have %zu\n", (size_t)WS_NEED, ws_size);
    p.phase_lo = 0; p.phase_hi = N_PHASE - 1;
    (void)hipMemsetAsync(p.bar(), 0, (size_t)(XCD_BAR_WORDS + 64 + 4096) * 4, stream);
    void* args[] = {&p};
    hipError_t e = hipLaunchCooperativeKernel((const void*)fwd_megakernel, dim3(grid_blocks), dim3(NTHR), args, LDS_BYTES, stream);
    if (e != hipSuccess) fprintf(stderr, "cooperative launch failed: %s (grid %d)\n", hipGetErrorString(e), grid_blocks);
}
```
